# Optimizing an MI355X kernel written in HIP

```python
import math
import jax, jax.numpy as jnp
from jax import lax
import numpy as np

D_MODEL = 2048
BATCH = 4
SEQ = 4096
DEPTH = 2

GRID_W = 64
Q_BLOCK = 128
NORM_EPS = 1e-6
ROPE_THETA = 10000.0
NEG_INF = -1e30

A_HEADS = 8
A_DQK = 64
A_DV = 2 * A_DQK
A_WIDTH = A_HEADS * A_DV
B_HEADS = 8
B_NOPE = 128
B_ROPE = 64
B_DV = 128
B_Q_RANK = 768
B_KV_RANK = 512
B_WIDTH = B_HEADS * B_DV
C_HEADS = 8
C_DH = 128
C_WIDTH = C_HEADS * C_DH
NA_KH = 8
NA_KW = 16
D_HEADS = 8
D_KV_HEADS = 2
D_DH = 128
D_WIDTH = D_HEADS * D_DH

EVEN_SPLITS = (A_HEADS * 2 * A_DQK, A_HEADS * 2 * A_DQK, A_WIDTH, A_WIDTH,
               B_Q_RANK, B_KV_RANK, B_ROPE, B_WIDTH)
ODD_SPLITS = (C_WIDTH, C_WIDTH, C_WIDTH, C_WIDTH,
              D_HEADS * D_DH, D_KV_HEADS * D_DH, D_KV_HEADS * D_DH, D_WIDTH)
EVEN_IN = sum(EVEN_SPLITS)
ODD_IN = sum(ODD_SPLITS)
N_EVEN = (DEPTH + 1) // 2
N_ODD = DEPTH // 2

kernel_name = "hybrid_diffattn_mla_natten_axialgqa_encoder"


def rms_norm(x, gain):
    xf = x.astype(jnp.float32)
    y = xf * lax.rsqrt(jnp.mean(xf * xf, axis=-1, keepdims=True) + NORM_EPS)
    return (y * gain.astype(jnp.float32)).astype(x.dtype)


def split_cols(h, sizes):
    idx = np.cumsum(sizes)[:-1].tolist()
    return jnp.split(h, idx, axis=-1)


def rope(x, pos):
    half = x.shape[-1] // 2
    inv = ROPE_THETA ** (-jnp.arange(half, dtype=jnp.float32) / half)
    ang = pos.astype(jnp.float32)[:, None] * inv[None, :]
    shape = (1, x.shape[1]) + (1,) * (x.ndim - 3) + (half,)
    cos, sin = jnp.cos(ang).reshape(shape), jnp.sin(ang).reshape(shape)
    xf = x.astype(jnp.float32)
    x1, x2 = xf[..., :half], xf[..., half:]
    return jnp.concatenate([x1 * cos - x2 * sin, x1 * sin + x2 * cos], axis=-1).astype(x.dtype)


def axial_rope(x, row, col):
    half = x.shape[-1] // 2
    return jnp.concatenate([rope(x[..., :half], row), rope(x[..., half:], col)], axis=-1)


def to_blocks(t):
    b, s = t.shape[:2]
    return jnp.moveaxis(t.reshape((b, s // Q_BLOCK, Q_BLOCK) + t.shape[2:]), 1, 0)


def from_blocks(t):
    t = jnp.moveaxis(t, 0, 1)
    return t.reshape((t.shape[0], t.shape[1] * t.shape[2]) + t.shape[3:])


def diff_attention(q, k, v, lam, subln, lambda_init):
    b, s = q.shape[:2]
    q = q.reshape(b, s, A_HEADS, 2, A_DQK)
    k = k.reshape(b, s, A_HEADS, 2, A_DQK)
    v = v.reshape(b, s, A_HEADS, A_DV)
    pos = jnp.arange(s, dtype=jnp.float32)
    slopes = 2.0 ** (-8.0 * jnp.arange(1, A_HEADS + 1, dtype=jnp.float32) / A_HEADS)
    scale = A_DQK ** -0.5

    def block(args):
        qb, pb = args
        sc = jnp.einsum('bqhmd,bkhmd->bhmqk', qb, k).astype(jnp.float32) * scale
        alibi = -slopes[:, None, None] * jnp.abs(pb[:, None] - pos[None, :])[None]
        p = jax.nn.softmax(sc + alibi[None, :, None], axis=-1)
        w = p[:, :, 0] - lam * p[:, :, 1]
        return jnp.einsum('bhqk,bkhd->bqhd', w.astype(v.dtype), v)

    o = from_blocks(lax.map(block, (to_blocks(q), pos.reshape(-1, Q_BLOCK))))
    o = rms_norm(o, subln) * (1.0 - lambda_init)
    return o.reshape(b, s, A_WIDTH)


def latent_attention(cq, ckv, k_rope, q_norm, w_uq, kv_norm, w_ukv):
    b, s = cq.shape[:2]
    pos = jnp.arange(s)
    q = (rms_norm(cq, q_norm) @ w_uq).reshape(b, s, B_HEADS, B_NOPE + B_ROPE)
    q_nope, q_pe = q[..., :B_NOPE], rope(q[..., B_NOPE:], pos)
    kv = (rms_norm(ckv, kv_norm) @ w_ukv).reshape(b, s, B_HEADS, B_NOPE + B_DV)
    k_nope, v = kv[..., :B_NOPE], kv[..., B_NOPE:]
    k_pe = rope(k_rope, pos)
    scale = (B_NOPE + B_ROPE) ** -0.5

    def block(args):
        qn, qp = args
        sc = (jnp.einsum('bqhd,bkhd->bhqk', qn, k_nope)
              + jnp.einsum('bqhr,bkr->bhqk', qp, k_pe))
        p = jax.nn.softmax(sc.astype(jnp.float32) * scale, axis=-1)
        return jnp.einsum('bhqk,bkhd->bqhd', p.astype(v.dtype), v)

    o = from_blocks(lax.map(block, (to_blocks(q_nope), to_blocks(q_pe))))
    return o.reshape(b, s, B_WIDTH)


def neighbourhood_attention(q, k, v, rpb):
    b, s = q.shape[:2]
    rows = s // GRID_W
    kh = min(NA_KH, rows)
    scale = C_DH ** -0.5
    qg = q.reshape(b, rows, GRID_W, C_HEADS, C_DH)
    kg = k.reshape(b, rows, GRID_W, C_HEADS, C_DH)
    vg = v.reshape(b, rows, GRID_W, C_HEADS, C_DH)
    r = jnp.arange(rows)
    r0 = jnp.clip(r - kh // 2, 0, rows - kh)
    row_idx = r0[:, None] + jnp.arange(kh)[None, :]
    kb = kg[:, row_idx]
    vb = vg[:, row_idx]
    c = jnp.arange(GRID_W)
    c0 = jnp.clip(c - NA_KW // 2, 0, GRID_W - NA_KW)
    col_in = (c[None, :] >= c0[:, None]) & (c[None, :] < c0[:, None] + NA_KW)
    dr = row_idx - r[:, None] + NA_KH - 1
    dc = jnp.clip(c[None, :] - c[:, None], -(NA_KW - 1), NA_KW - 1) + NA_KW - 1
    bias = rpb[:, dr[:, None, :, None], dc[None, :, None, :]]
    sc = jnp.einsum('brqhd,brkwhd->bhrqkw', qg, kb).astype(jnp.float32) * scale + bias[None]
    sc = jnp.where(col_in[:, None, :], sc, NEG_INF)
    p = jax.nn.softmax(sc, axis=(-2, -1))
    o = jnp.einsum('bhrqkw,brkwhd->brqhd', p.astype(vb.dtype), vb)
    return o.reshape(b, s, C_WIDTH)


def axial_gqa(q, k, v, q_norm, k_norm):
    b, s = q.shape[:2]
    t = jnp.arange(s)
    row, col = t // GRID_W, t % GRID_W
    q = axial_rope(rms_norm(q.reshape(b, s, D_HEADS, D_DH), q_norm), row, col)
    k = axial_rope(rms_norm(k.reshape(b, s, D_KV_HEADS, D_DH), k_norm), row, col)
    q = q.reshape(b, s, D_KV_HEADS, D_HEADS // D_KV_HEADS, D_DH)
    v = v.reshape(b, s, D_KV_HEADS, D_DH)
    scale = D_DH ** -0.5

    def block(qb):
        sc = jnp.einsum('bqhgd,bkhd->bhgqk', qb, k).astype(jnp.float32) * scale
        p = jax.nn.softmax(sc, axis=-1)
        return jnp.einsum('bhgqk,bkhd->bqhgd', p.astype(v.dtype), v)

    o = from_blocks(lax.map(block, to_blocks(q)))
    return o.reshape(b, s, D_WIDTH)


def even_mixer(h, w_in, w_out, lq1, lk1, lq2, lk2, subln, q_norm, w_uq, kv_norm, w_ukv, lambda_init):
    qa, ka, va, ga, cq, ckv, kr, gb = split_cols(h @ w_in, EVEN_SPLITS)
    lam = (jnp.exp(jnp.sum(lq1.astype(jnp.float32) * lk1.astype(jnp.float32)))
           - jnp.exp(jnp.sum(lq2.astype(jnp.float32) * lk2.astype(jnp.float32))) + lambda_init)
    oa = diff_attention(qa, ka, va, lam, subln, lambda_init) * jax.nn.silu(ga)
    ob = latent_attention(cq, ckv, kr, q_norm, w_uq, kv_norm, w_ukv) * jax.nn.silu(gb)
    return jnp.concatenate([oa, ob], axis=-1) @ w_out


def odd_mixer(h, w_in, w_out, rpb, q_norm, k_norm):
    qc, kc, vc, gc, qd, kd, vd, gd = split_cols(h @ w_in, ODD_SPLITS)
    oc = neighbourhood_attention(qc, kc, vc, rpb) * jax.nn.silu(gc)
    od = axial_gqa(qd, kd, vd, q_norm, k_norm) * jax.nn.silu(gd)
    return jnp.concatenate([oc, od], axis=-1) @ w_out


def setup_inputs(seed: int = 0) -> dict:
    key = jax.random.key(seed)
    ks = jax.random.split(key, 20)

    def nrm(k, shape, scale):
        return jax.random.normal(k, shape, jnp.float32) * scale

    def gain(k, shape):
        return 1.0 + 0.02 * jax.random.normal(k, shape, jnp.float32)

    return {
        "x": nrm(ks[0], (BATCH, SEQ, D_MODEL), 1.0),
        "pre_norm": gain(ks[1], (DEPTH, D_MODEL)),
        "post_norm": gain(ks[2], (DEPTH, D_MODEL)),
        "even_w_in": nrm(ks[3], (N_EVEN, D_MODEL, EVEN_IN), D_MODEL ** -0.5),
        "even_w_out": nrm(ks[4], (N_EVEN, A_WIDTH + B_WIDTH, D_MODEL), (A_WIDTH + B_WIDTH) ** -0.5),
        "diff_lambda_q1": nrm(ks[5], (N_EVEN, A_DQK), 0.1),
        "diff_lambda_k1": nrm(ks[6], (N_EVEN, A_DQK), 0.1),
        "diff_lambda_q2": nrm(ks[7], (N_EVEN, A_DQK), 0.1),
        "diff_lambda_k2": nrm(ks[8], (N_EVEN, A_DQK), 0.1),
        "diff_subln": gain(ks[9], (N_EVEN, A_DV)),
        "mla_q_norm": gain(ks[10], (N_EVEN, B_Q_RANK)),
        "mla_w_uq": nrm(ks[11], (N_EVEN, B_Q_RANK, B_HEADS * (B_NOPE + B_ROPE)), B_Q_RANK ** -0.5),
        "mla_kv_norm": gain(ks[12], (N_EVEN, B_KV_RANK)),
        "mla_w_ukv": nrm(ks[13], (N_EVEN, B_KV_RANK, B_HEADS * (B_NOPE + B_DV)), B_KV_RANK ** -0.5),
        "odd_w_in": nrm(ks[14], (N_ODD, D_MODEL, ODD_IN), D_MODEL ** -0.5),
        "odd_w_out": nrm(ks[15], (N_ODD, C_WIDTH + D_WIDTH, D_MODEL), (C_WIDTH + D_WIDTH) ** -0.5),
        "na_rpb": nrm(ks[16], (N_ODD, C_HEADS, 2 * NA_KH - 1, 2 * NA_KW - 1), 0.1),
        "gqa_q_norm": gain(ks[17], (N_ODD, D_DH)),
        "gqa_k_norm": gain(ks[18], (N_ODD, D_DH)),
    }


def reference(x, pre_norm, post_norm, even_w_in, even_w_out, diff_lambda_q1, diff_lambda_k1,
              diff_lambda_q2, diff_lambda_k2, diff_subln, mla_q_norm, mla_w_uq, mla_kv_norm,
              mla_w_ukv, odd_w_in, odd_w_out, na_rpb, gqa_q_norm, gqa_k_norm):
    for layer in range(DEPTH):
        i = layer // 2
        h = rms_norm(x, pre_norm[layer])
        if layer % 2 == 0:
            lambda_init = 0.8 - 0.6 * math.exp(-0.3 * layer)
            m = even_mixer(h, even_w_in[i], even_w_out[i], diff_lambda_q1[i], diff_lambda_k1[i],
                           diff_lambda_q2[i], diff_lambda_k2[i], diff_subln[i], mla_q_norm[i],
                           mla_w_uq[i], mla_kv_norm[i], mla_w_ukv[i], lambda_init)
        else:
            m = odd_mixer(h, odd_w_in[i], odd_w_out[i], na_rpb[i], gqa_q_norm[i], gqa_k_norm[i])
        x = x + rms_norm(m, post_norm[layer])
    return x
```

```cpp
#include <hip/hip_runtime.h>
#include <hip/hip_bf16.h>
#include <cstdio>
#include <cstdint>
#include <cmath>
__device__ __forceinline__ int fresh_tid() { int t = threadIdx.x; asm volatile("" : "+v"(t)); return t; }
namespace pg8 {
#define PG8_LAS __attribute__((address_space(3)))
typedef unsigned short bf16_t;
typedef short bf16x8 __attribute__((ext_vector_type(8)));
typedef float f32x4 __attribute__((ext_vector_type(4)));
typedef unsigned u32x4 __attribute__((ext_vector_type(4)));
constexpr int BM = 256, BK = 64, HALF = 128, HTB = HALF * BK * 2  , STAGE_BYTES = 8 * HTB, NXCD = 8, WGM = 8;

__host__ __device__ __forceinline__ int lds_byte(int r, int c) { const int st = (r >> 4) * 2 + (c >> 5), rr = r & 15, cc = c & 31, ob = rr * 64 + cc * 2; return st * 1024 + (ob ^ (((ob >> 9) & 1) << 5)); }
__host__ __device__ __forceinline__ void stage_rc(int b, int& R, int& C) { const int st = b / 1024, sb = b % 1024, swz = sb ^ (((sb >> 9) & 1) << 5); R = (st >> 1) * 16 + swz / 64; C = (st & 1) * 32 + (swz % 64) / 2; }
__host__ __device__ __forceinline__ int perm32(int rho) { const int n = rho >> 4, i = rho & 15; return 8 * (i >> 2) + 4 * n + (i & 3); }

struct Unit { int pm, pn; };
struct Gemm { const bf16_t* A; const bf16_t* Bt; int M, N, K, lda; };

struct StaticOrder {
    int nM, nN, nwg, G, c;
    __host__ __device__ void init(int M, int N, int G_, int c_) { nM = M / BM; nN = N / BM; nwg = nM * nN; G = G_; c = c_; }
    __host__ __device__ bool next(int i, Unit& u) const {
        const long L = (long)i * G + c; if (L >= nwg) return false;
        int wgid = (int)L; { const int q = nwg / NXCD, r = nwg % NXCD, xcd = wgid % NXCD, off = wgid / NXCD; wgid = (xcd < r ? xcd * (q + 1) : r * (q + 1) + (xcd - r) * q) + off; }
        const int nig = WGM * nN, gid = wgid / nig, fm = gid * WGM, gsz = (nM - fm) < WGM ? (nM - fm) : WGM;
        u.pm = fm + ((wgid % nig) % gsz); u.pn = (wgid % nig) / gsz; return true;
    }
    __device__ __forceinline__ void a_ready(const Unit&) const {}
    __device__ __forceinline__ void done(const Unit&) const {}
};
struct SplitOrder : StaticOrder {
    int nlo, lo, hi;
    __host__ __device__ bool next(int i, Unit& u) const {
        long L;
        if (c < nlo) { if (i >= lo) return false; L = (long)hi * (G - nlo) + (long)i * nlo + c; }
        else { if (i >= hi) return false; L = (long)i * (G - nlo) + (c - nlo); }
        if (L >= nwg) return false;
        int wgid = (int)L; { const int q = nwg / NXCD, r = nwg % NXCD, xcd = wgid % NXCD, off = wgid / NXCD; wgid = (xcd < r ? xcd * (q + 1) : r * (q + 1) + (xcd - r) * q) + off; }
        const int nig = WGM * nN, gid = wgid / nig, fm = gid * WGM, gsz = (nM - fm) < WGM ? (nM - fm) : WGM;
        u.pm = fm + ((wgid % nig) % gsz); u.pn = (wgid % nig) / gsz; return true;
    }
};
__device__ __forceinline__ unsigned cvt_pk_bf16(float lo, float hi) { unsigned r; asm volatile("v_cvt_pk_bf16_f32 %0, %1, %2" : "=v"(r) : "v"(lo), "v"(hi)); return r; }
typedef unsigned u32x4e __attribute__((ext_vector_type(4)));
struct EpiOut {
    static constexpr bool PERM = true, AFTER_DRAIN = false;
    bf16_t* O; int ldc;
    const float* rs_in; int rs_ld, rs_n; float rs_invk, rs_eps;
    float* ss_out; int ss_ld, ss_pn0, ss_pn1;
    unsigned* kmax;
    __device__ __forceinline__ void operator()(const f32x4 (&acc)[2][2][4][2], const Unit& u, int wr, int wc, int fr, int fq) const {
        const int row0 = u.pm * BM + wr * 64 + fr;
        const int col0 = u.pn * BM + wc * 32 + 8 * fq;
        const bool do_ss = (ss_out != nullptr) && (u.pn >= ss_pn0) && (u.pn < ss_pn1);
        float kmx = 0.f;
#pragma unroll
        for (int ai = 0; ai < 2; ++ai) {
            float rsc[4];
            if (rs_in) { f32x4 part[4][3];
#pragma unroll
                for (int q = 0; q < 4; ++q) { const float* p = rs_in + (size_t)(row0 + ai * HALF + q * 16) * rs_ld;
#pragma unroll
                    for (int i = 0; i < 3; ++i) part[q][i] = (4 * i < rs_n) ? *(const f32x4*)(p + 4 * i) : (f32x4){0.f, 0.f, 0.f, 0.f}; }
#pragma unroll
                for (int q = 0; q < 4; ++q) { float s = 0.f;
#pragma unroll
                    for (int i = 0; i < 3; ++i) s += (part[q][i][0] + part[q][i][1]) + (part[q][i][2] + part[q][i][3]);
                    rsc[q] = 1.0f / sqrtf(s * rs_invk + rs_eps); } }
            else {
#pragma unroll
                for (int q = 0; q < 4; ++q) rsc[q] = 1.f; }
#pragma unroll
            for (int m = 0; m < 4; ++m) {
                const int row = row0 + ai * HALF + m * 16;
                const float sc = rsc[m];
                bf16_t* rowp = O + (size_t)row * ldc + col0;
                float ssq = 0.f;
#pragma unroll
                for (int bj = 0; bj < 2; ++bj) {
                    const f32x4 v0 = acc[ai][bj][m][0] * sc, v1 = acc[ai][bj][m][1] * sc;
                    u32x4e w; w.x = cvt_pk_bf16(v0[0], v0[1]); w.y = cvt_pk_bf16(v0[2], v0[3]); w.z = cvt_pk_bf16(v1[0], v1[1]); w.w = cvt_pk_bf16(v1[2], v1[3]);
                    *(u32x4e*)(rowp + bj * HALF) = w;
                    if (do_ss) {
#pragma unroll
                        for (int e = 0; e < 4; ++e) { const float lo = __uint_as_float(w[e] << 16), hi = __uint_as_float(w[e] & 0xffff0000u); ssq += lo * lo + hi * hi; }
                    }
                    if (kmax && bj == 0) { float kn = 0.f;
#pragma unroll
                        for (int e = 0; e < 4; ++e) { const float lo = __uint_as_float(w[e] << 16), hi = __uint_as_float(w[e] & 0xffff0000u); kn += lo * lo + hi * hi; }
                        kn += __shfl_xor(kn, 16); kn += __shfl_xor(kn, 32); kmx = fmaxf(kmx, kn); }
                }
                if (do_ss) { ssq += __shfl_xor(ssq, 16); ssq += __shfl_xor(ssq, 32); if (fq == 0) ss_out[(size_t)row * ss_ld + (u.pn - ss_pn0) * 4 + wc] = ssq; }
            }
        }
        if (kmax) {
#pragma unroll
            for (int x = 1; x < 16; x <<= 1) kmx = fmaxf(kmx, __shfl_xor(kmx, x));
            if (fr == 0 && fq == 0) atomicMax(kmax + ((u.pm >> 4) * 8 + u.pn) * 4 + wc, __float_as_uint(kmx));
        }
    }
};
template <class Epi, class Sched, bool ALIGN_EPI = false, bool SP2 = false>
__device__ __forceinline__ void gemm_phase(PG8_LAS unsigned char* lds, const Gemm g, const Sched& S, const Epi& E) {
    const int tid = fresh_tid(), wid = __builtin_amdgcn_readfirstlane(tid >> 6), lane = tid & 63, wr = wid >> 2, wc = wid & 3, fr = lane & 15, fq = lane >> 4;
    const int K = g.K, nt = K / BK;
    unsigned voffA[2], voffB[2];
#pragma unroll
    for (int i = 0; i < 2; ++i) { int R, C; stage_rc(tid * 16 + i * 8192, R, C); const int Rb = Epi::PERM ? ((R & ~31) + perm32(R & 31)) : R;
        voffA[i] = (unsigned)(R * g.lda + C) * 2u; voffB[i] = (unsigned)(Rb * K + C) * 2u; }
    const size_t kstep = (size_t)(BK * 2);
    const size_t hstepA = (size_t)HALF * g.lda * 2, hstepB = (size_t)HALF * K * 2;
    const size_t tstepA = 2 * hstepA, tstepB = 2 * hstepB;
    const unsigned ldsw = (unsigned)wid * 1024u;
    const int aoff = lds_byte(wr * 64 + fr, fq * 8), boff = lds_byte(wc * 32 + fr, fq * 8);
#define PG8_SA(b, h) (((b) * 2 + (h)) * HTB)
#define PG8_SB(b, h) ((4 + (b) * 2 + (h)) * HTB)
#define PG8_STAGE(bufoff, gbase, voff) do { _Pragma("unroll") for (int _i = 0; _i < 2; ++_i) \
        __builtin_amdgcn_global_load_lds((const unsigned*)((const char*)(gbase) + (voff)[_i]), (PG8_LAS unsigned*)(lds + (bufoff) + ldsw + _i * 8192), 16, 0, 0); } while (0)
#define PG8_LDA(dst, b, h) do { _Pragma("unroll") for (int m = 0; m < 4; ++m) _Pragma("unroll") for (int k = 0; k < 2; ++k) dst[m][k] = *(const PG8_LAS bf16x8*)(lds + PG8_SA(b, h) + aoff + m * 2048 + k * 1024); } while (0)
#define PG8_LDB(dst, b, h) do { _Pragma("unroll") for (int n = 0; n < 2; ++n) _Pragma("unroll") for (int k = 0; k < 2; ++k) dst[n][k] = *(const PG8_LAS bf16x8*)(lds + PG8_SB(b, h) + boff + n * 2048 + k * 1024); } while (0)
#define PG8_MMA(ai, bj, At, Bt) do { __builtin_amdgcn_s_setprio(1); _Pragma("unroll") for (int m = 0; m < 4; ++m) _Pragma("unroll") for (int n = 0; n < 2; ++n) _Pragma("unroll") for (int k = 0; k < 2; ++k) \
        acc[ai][bj][m][n] = __builtin_amdgcn_mfma_f32_16x16x32_bf16(Bt[n][k], At[m][k], acc[ai][bj][m][n], 0, 0, 0); __builtin_amdgcn_s_setprio(0); } while (0)
#define PG8_WAIT_V(n) asm volatile("s_waitcnt vmcnt(" #n ")" ::: "memory")
#define PG8_WAIT_L(n) asm volatile("s_waitcnt lgkmcnt(" #n ")" ::: "memory")
#define PG8_BAR __builtin_amdgcn_s_barrier()
#define PG8_SCHED __builtin_amdgcn_sched_barrier(0)
    Unit cur, nxt; int ui = 0;
    if (!S.next(0, cur)) return;
    f32x4 acc[2][2][4][2];
#pragma unroll
    for (int a = 0; a < 2; ++a)
#pragma unroll
        for (int b = 0; b < 2; ++b)
#pragma unroll
            for (int m = 0; m < 4; ++m)
#pragma unroll
                for (int n = 0; n < 2; ++n) acc[a][b][m][n] = (f32x4){0.f, 0.f, 0.f, 0.f};
    bf16x8 At[4][2], B0[2][2], B1[2][2];
    const char* cA = (const char*)g.A + (size_t)cur.pm * tstepA; const char* cB = (const char*)g.Bt + (size_t)cur.pn * tstepB;
    S.a_ready(cur);
    if constexpr (SP2) {
        PG8_STAGE(PG8_SB(0, 0), cB, voffB); PG8_STAGE(PG8_SB(0, 1), cB + hstepB, voffB); PG8_STAGE(PG8_SA(0, 0), cA, voffA); PG8_STAGE(PG8_SA(0, 1), cA + hstepA, voffA);
        if (wr == 1) PG8_BAR;
        PG8_WAIT_V(2); PG8_BAR;
        PG8_STAGE(PG8_SB(1, 0), cB + kstep, voffB); PG8_STAGE(PG8_SA(1, 0), cA + kstep, voffA); PG8_STAGE(PG8_SB(1, 1), cB + hstepB + kstep, voffB);
        PG8_WAIT_V(6); PG8_BAR;
    } else {
        PG8_STAGE(PG8_SB(0, 0), cB, voffB); PG8_STAGE(PG8_SA(0, 0), cA, voffA); PG8_STAGE(PG8_SB(0, 1), cB + hstepB, voffB); PG8_STAGE(PG8_SA(0, 1), cA + hstepA, voffA);
        if (wr == 1) PG8_BAR;
        PG8_WAIT_V(4); PG8_BAR;
        PG8_STAGE(PG8_SB(1, 0), cB + kstep, voffB); PG8_STAGE(PG8_SA(1, 0), cA + kstep, voffA); PG8_STAGE(PG8_SB(1, 1), cB + hstepB + kstep, voffB);
        PG8_WAIT_V(6); PG8_BAR;
    }
    for (;;) {
        const bool has_next = S.next(ui + 1, nxt);
        const char* nA = has_next ? (const char*)g.A + (size_t)nxt.pm * tstepA : cA; const char* nB = has_next ? (const char*)g.Bt + (size_t)nxt.pn * tstepB : cB;
        for (int t = 0; t < nt; t += 2) {
            const bool last = (t == nt - 2);
            const char* a1 = cA + (size_t)(t + 1) * kstep;
            const char* a2 = last ? nA : cA + (size_t)(t + 2) * kstep; const char* b2 = last ? nB : cB + (size_t)(t + 2) * kstep;
            const char* a3 = a2 + kstep; const char* b3 = b2 + kstep;
            if (last && has_next) S.a_ready(nxt);
            if constexpr (SP2) {
            PG8_LDB(B0, 0, 0); PG8_LDB(B1, 0, 1); PG8_SCHED; PG8_LDA(At, 0, 0); PG8_STAGE(PG8_SA(1, 1), a1 + hstepA, voffA);
            PG8_WAIT_V(8); PG8_WAIT_L(0); PG8_BAR; PG8_MMA(0, 0, At, B0); PG8_MMA(0, 1, At, B1); PG8_BAR; PG8_SCHED;
            PG8_LDA(At, 0, 1); PG8_STAGE(PG8_SB(0, 0), b2, voffB); PG8_STAGE(PG8_SB(0, 1), b2 + hstepB, voffB); PG8_STAGE(PG8_SA(0, 0), a2, voffA);
            PG8_WAIT_V(8); PG8_WAIT_L(0); PG8_BAR; PG8_MMA(1, 0, At, B0); PG8_MMA(1, 1, At, B1); PG8_BAR; PG8_SCHED;
            PG8_LDB(B0, 1, 0); PG8_LDB(B1, 1, 1); PG8_SCHED; PG8_LDA(At, 1, 0); PG8_STAGE(PG8_SA(0, 1), a2 + hstepA, voffA);
            PG8_WAIT_V(8); PG8_WAIT_L(0); PG8_BAR; PG8_MMA(0, 0, At, B0); PG8_MMA(0, 1, At, B1); PG8_BAR; PG8_SCHED;
            PG8_LDA(At, 1, 1); PG8_STAGE(PG8_SB(1, 0), b3, voffB); PG8_STAGE(PG8_SB(1, 1), b3 + hstepB, voffB); PG8_STAGE(PG8_SA(1, 0), a3, voffA);
            PG8_WAIT_V(8); PG8_WAIT_L(0); PG8_BAR; PG8_MMA(1, 0, At, B0); PG8_MMA(1, 1, At, B1); PG8_BAR; PG8_SCHED;
            } else {
            PG8_LDB(B0, 0, 0); PG8_SCHED; PG8_LDA(At, 0, 0); PG8_STAGE(PG8_SA(1, 1), a1 + hstepA, voffA);
            PG8_WAIT_L(8); PG8_BAR; PG8_WAIT_L(0); PG8_MMA(0, 0, At, B0); PG8_BAR; PG8_SCHED;
            PG8_LDB(B1, 0, 1); PG8_STAGE(PG8_SB(0, 0), b2, voffB);
            PG8_BAR; PG8_WAIT_L(0); PG8_MMA(0, 1, At, B1); PG8_BAR;
            PG8_LDA(At, 0, 1); PG8_STAGE(PG8_SA(0, 0), a2, voffA);
            PG8_BAR; PG8_WAIT_L(0); PG8_MMA(1, 0, At, B0); PG8_BAR; PG8_SCHED;
            PG8_STAGE(PG8_SB(0, 1), b2 + hstepB, voffB);
            PG8_WAIT_V(6); PG8_BAR; PG8_MMA(1, 1, At, B1); PG8_BAR;
            PG8_LDB(B0, 1, 0); PG8_SCHED; PG8_LDA(At, 1, 0); PG8_STAGE(PG8_SA(0, 1), a2 + hstepA, voffA);
            PG8_WAIT_L(8); PG8_BAR; PG8_WAIT_L(0); PG8_MMA(0, 0, At, B0); PG8_BAR; PG8_SCHED;
            PG8_LDB(B1, 1, 1); PG8_STAGE(PG8_SB(1, 0), b3, voffB);
            PG8_BAR; PG8_WAIT_L(0); PG8_MMA(0, 1, At, B1); PG8_BAR;
            PG8_LDA(At, 1, 1); PG8_STAGE(PG8_SA(1, 0), a3, voffA);
            PG8_BAR; PG8_WAIT_L(0); PG8_MMA(1, 0, At, B0); PG8_BAR; PG8_SCHED;
            PG8_STAGE(PG8_SB(1, 1), b3 + hstepB, voffB);
            PG8_WAIT_V(6); PG8_BAR; PG8_MMA(1, 1, At, B1); PG8_BAR;
            }
        }
        if constexpr (ALIGN_EPI) { if (wr == 0) PG8_BAR; }
        if constexpr (!Epi::AFTER_DRAIN) { E(acc, cur, wr, wc, fr, fq); S.done(cur); }
        if (!has_next) break;
#pragma unroll
        for (int a = 0; a < 2; ++a)
#pragma unroll
            for (int b = 0; b < 2; ++b)
#pragma unroll
                for (int m = 0; m < 4; ++m)
#pragma unroll
                    for (int n = 0; n < 2; ++n) acc[a][b][m][n] = (f32x4){0.f, 0.f, 0.f, 0.f};
        cur = nxt; cA = nA; cB = nB; ++ui;
        if constexpr (ALIGN_EPI) { if (wr == 1) PG8_BAR; }
    }
    PG8_WAIT_V(0);
    if constexpr (!ALIGN_EPI) { if (wr == 0) PG8_BAR; }
    PG8_BAR;
    if constexpr (Epi::AFTER_DRAIN) { E.fused(acc, cur, wr, wc, fr, fq, lds, wid, lane); S.done(cur); }
#undef PG8_SA
#undef PG8_SB
#undef PG8_STAGE
#undef PG8_LDA
#undef PG8_LDB
#undef PG8_MMA
#undef PG8_WAIT_V
#undef PG8_WAIT_L
#undef PG8_BAR
#undef PG8_SCHED
}
}
#ifndef GEMM_SP2
#define GEMM_SP2 true
#endif
#ifndef GEMM_ALIGN
#define GEMM_ALIGN true
#endif
#ifndef SINGLE_LAUNCH
#define SINGLE_LAUNCH 1
#endif
constexpr int NB = 4, SEQ = 4096, DM = 2048, MTOK = NB * SEQ;
constexpr int NIN = 6656;
constexpr float EPS = 1e-6f, LOG2E = 1.4426950408889634f;
constexpr int E_QA = 0, E_KA = 1024, E_VA = 2048, E_GA = 3072, E_CQ = 4096, E_CKV = 4864, E_GB = 5376, E_KR = 6400;
constexpr int O_QC = 0, O_KC = 1024, O_VC = 2048, O_GC = 3072, O_QD = 4096, O_KD = 5120, O_VD = 5376, O_GD = 5632;
constexpr int QMW = 1536, KVW = 2048;
constexpr int SSLD = 20;

constexpr size_t MiB = 1u << 20;
constexpr size_t WS_CTL = 0, CTL_ZERO_BYTES = 64 * 1024;
constexpr size_t WS_TAB = 1 * MiB;
constexpr size_t WS_RSS = 2 * MiB;
constexpr size_t WS_SSQ = 4 * MiB;
constexpr size_t WS_CONST = 6 * MiB;
constexpr size_t WS_WIN0 = 8 * MiB, WS_WOUT0 = 34 * MiB, WS_WUQ = 42 * MiB, WS_WUKV = 45 * MiB, WS_WIN1 = 47 * MiB, WS_WOUT1 = 73 * MiB;
constexpr size_t WS_XN = 96 * MiB;
constexpr size_t WS_KVM = WS_XN;
constexpr size_t WS_H1 = 160 * MiB;
constexpr size_t WS_MB = WS_H1;
constexpr size_t WS_QM = 368 * MiB;
constexpr size_t WS_X1B = 368 * MiB;
constexpr size_t WS_ATT = 432 * MiB;
constexpr size_t WS_KPE = 496 * MiB;
constexpr size_t WS_KG = 498 * MiB;
constexpr size_t WS_END = 506 * MiB;
constexpr int CW_BAR = 4096, CW_KMAX = 8192, CW_QCTR = 12288;

constexpr int RING_OFF = 0, RING_BYTES = 131072;
constexpr int LDSCTL_OFF = RING_BYTES, MISC_OFF = LDSCTL_OFF + 320;
constexpr int LDS_BYTES = 147456;
constexpr int NWAVES = 8;

#define GAS __attribute__((address_space(1)))
#define LAS __attribute__((address_space(3)))
typedef unsigned short bf16;
typedef unsigned v4u __attribute__((ext_vector_type(4)));
typedef unsigned v2u __attribute__((ext_vector_type(2)));
typedef float f32x4 __attribute__((ext_vector_type(4)));
typedef float f32x2 __attribute__((ext_vector_type(2)));
typedef GAS unsigned gu32;
#define RLX_AGENT __ATOMIC_RELAXED, __HIP_MEMORY_SCOPE_AGENT
#define LDS_WAIT() asm volatile("s_waitcnt lgkmcnt(0)" ::: "memory")
#define VM_WAIT() asm volatile("s_waitcnt vmcnt(0)" ::: "memory")
__device__ __forceinline__ unsigned f2bf(float f) { unsigned u = __builtin_bit_cast(unsigned, f); return (u + 0x7fffu + ((u >> 16) & 1u)) >> 16; }
__device__ __forceinline__ unsigned pk2(float lo, float hi) { return f2bf(lo) | (f2bf(hi) << 16); }
__device__ __forceinline__ float bflo(unsigned w) { return __uint_as_float(w << 16); }
__device__ __forceinline__ float bfhi(unsigned w) { return __uint_as_float(w & 0xffff0000u); }
__device__ __forceinline__ float bf1(bf16 u) { return __uint_as_float((unsigned)u << 16); }
__device__ __forceinline__ float silu(float x) { return x / (1.0f + __expf(-x)); }
__device__ __forceinline__ float wave_sum(float v) {
#pragma unroll
    for (int o = 1; o < 64; o <<= 1) v += __shfl_xor(v, o);
    return v;
}
__device__ __forceinline__ float wave_max(float v) {
#pragma unroll
    for (int o = 1; o < 64; o <<= 1) v = fmaxf(v, __shfl_xor(v, o));
    return v;
}

#define XB_TMO      128
#define XB_XCNT(j)  (256  + 64 * (j))
#define XB_XSUB(j)  (1280 + 64 * (j))
#define XB_XGEN(j)  (2304 + 64 * (j))
#define XB_TOP      3328
#define XB_TOPGEN   3392
#define XCD_BAR_WORDS 3456
#define XB_SPIN_CAP (1u << 18)

__device__ __forceinline__ unsigned xb_ld(unsigned* p)              { return __hip_atomic_load(p, __ATOMIC_RELAXED, __HIP_MEMORY_SCOPE_AGENT); }
__device__ __forceinline__ unsigned xb_add(unsigned* p, unsigned v) { return __hip_atomic_fetch_add(p, v, __ATOMIC_RELAXED, __HIP_MEMORY_SCOPE_AGENT); }
__device__ __forceinline__ unsigned xb_xcc_id() { return (unsigned)__builtin_amdgcn_s_getreg((3 << 11) | 20) & 0xFu; }
#define XB_SPIN(cond, bar) do { unsigned _sp = 0; while (cond) { __builtin_amdgcn_s_sleep(1); \
    if ((++_sp & 255u) == 0u) { if (xb_ld(&(bar)[XB_TMO])) break; if (_sp > XB_SPIN_CAP) { atomicAdd(&(bar)[XB_TMO], 1u); break; } } } } while (0)

struct XcdBarrier {
    unsigned* bar; unsigned x;
    volatile LAS unsigned* st;
};

__device__ __forceinline__ XcdBarrier xcd_barrier_post(unsigned* bar, volatile LAS unsigned* st) {
    XcdBarrier b; b.bar = bar; b.x = xb_xcc_id(); b.st = st;
    if (threadIdx.x == 0) (void)xb_add(&bar[XB_XCNT(b.x)], 1u);
    return b;
}
__device__ __forceinline__ void xcd_barrier_complete(unsigned* bar, unsigned x, unsigned& nloc, unsigned& nx) {
    const unsigned G = gridDim.x * gridDim.y * gridDim.z;
    unsigned sum, cnt, mine, sp = 0u;
    for (;;) {
        sum = 0u; cnt = 0u; mine = 0u;
#pragma unroll
        for (unsigned j = 0; j < 16; ++j) { const unsigned c = xb_ld(&bar[XB_XCNT(j)]); sum += c; cnt += (c > 0u) ? 1u : 0u; mine = (j == x) ? c : mine; }
        if (sum == G) break;
        __builtin_amdgcn_s_sleep(1);
        if ((++sp & 255u) == 0u) { if (xb_ld(&bar[XB_TMO])) break; if (sp > XB_SPIN_CAP) { atomicAdd(&bar[XB_TMO], 1u); break; } }
    }
    nloc = mine > 0u ? mine : 1u; nx = cnt > 0u ? cnt : 1u;
}

__device__ __forceinline__ void xcd_barrier(const XcdBarrier& b) {
    asm volatile("s_waitcnt vmcnt(0)" ::: "memory");
    __syncthreads();
    if (threadIdx.x == 0) {
        unsigned* bar = b.bar;
        __builtin_amdgcn_s_waitcnt(0);
        unsigned nloc = b.st[0], nx = b.st[1];
        if (nloc == 0u) { xcd_barrier_complete(bar, b.x, nloc, nx); b.st[0] = nloc; b.st[1] = nx; }
        const unsigned old = xb_add(&bar[XB_XSUB(b.x)], 1u);
        const unsigned gen = old / nloc;
        if (old + 1u == (gen + 1u) * nloc) {
            __builtin_amdgcn_fence(__ATOMIC_RELEASE, "agent");
            asm volatile("s_waitcnt vmcnt(0)" ::: "memory");
            const unsigned og = xb_add(&bar[XB_TOP], 1u);
            const unsigned tg = og / nx;
            if (og + 1u == (tg + 1u) * nx) xb_add(&bar[XB_TOPGEN], 1u);
            else XB_SPIN(xb_ld(&bar[XB_TOPGEN]) == tg, bar);
            __builtin_amdgcn_fence(__ATOMIC_ACQUIRE, "agent");
            xb_add(&bar[XB_XGEN(b.x)], 1u);
            asm volatile("s_waitcnt vmcnt(0)" ::: "memory");
        } else {
            XB_SPIN(xb_ld(&bar[XB_XGEN(b.x)]) == gen, bar);
            __builtin_amdgcn_fence(__ATOMIC_ACQUIRE, "agent");
            asm volatile("s_waitcnt vmcnt(0)" ::: "memory");
        }
    }
    __syncthreads();
}


#ifndef FA_PVP
#define FA_PVP 0
#endif
#ifndef FA_SETPRIO
#define FA_SETPRIO 0
#endif
#ifndef FA_PVDEP
#define FA_PVDEP 0
#endif
#ifndef FA_NOSB
#define FA_NOSB 0
#endif
#ifndef FA_MBIAS
#define FA_MBIAS 1
#endif
#ifndef FA_ALIGN_P2
#define FA_ALIGN_P2 6
#endif
#define FA_STR2(x) #x
#define FA_STR(x) FA_STR2(x)
#define FA_ALIGN() asm volatile(".p2align " FA_STR(FA_ALIGN_P2) ::: "memory")
namespace fa {
typedef short bf16x8 __attribute__((ext_vector_type(8)));
typedef short s16x4 __attribute__((ext_vector_type(4)));
typedef float f32x16 __attribute__((ext_vector_type(16)));
typedef unsigned u32x4 __attribute__((ext_vector_type(4)));
constexpr int R_V = 0, R_K1 = 49152, R_K2 = 98304;
constexpr int L_WS = 122880, L_RPB = 124928, L_QMAX = 127488, L_END = 127552;
constexpr int SHM_V = 16384, SHM_K1 = 16384, SHM_K2 = 8192;
constexpr float THR2 = 8.f;
#define FA_SBAR() __builtin_amdgcn_sched_barrier(0)
#define FA_KSWZ(row, colB) ((row) * 256 + ((colB) ^ (((row) & 15) << 4)))
#define FA_K2SWZ(row, ch) ((row) * 128 + ((((ch) ^ ((row) >> 1)) & 7) << 4))
__device__ __forceinline__ int crow(int r, int hi) { return (r & 3) + 8 * (r >> 2) + 4 * hi; }
template <int X> __device__ __forceinline__ float swz_xor(float v) { return __int_as_float(__builtin_amdgcn_ds_swizzle(__float_as_int(v), (X << 10) | 0x1f)); }
__device__ __forceinline__ unsigned cvtpk(float lo, float hi) { unsigned r; asm volatile("v_cvt_pk_bf16_f32 %0, %1, %2" : "=v"(r) : "v"(lo), "v"(hi)); return r; }
typedef __bf16 bf2c __attribute__((ext_vector_type(2))); typedef float f2c __attribute__((ext_vector_type(2)));
__device__ __forceinline__ unsigned cvtpk_c(float lo, float hi) { return __builtin_bit_cast(unsigned, __builtin_convertvector((f2c){lo, hi}, bf2c)); }
__device__ __forceinline__ bf16x8 pack8(const float* f) { u32x4 w = {cvtpk(f[0], f[1]), cvtpk(f[2], f[3]), cvtpk(f[4], f[5]), cvtpk(f[6], f[7])}; return __builtin_bit_cast(bf16x8, w); }
__device__ __forceinline__ void unpack8(bf16x8 v, float* f) { const u32x4 w = __builtin_bit_cast(u32x4, v);
    f[0] = __uint_as_float(w.x << 16); f[1] = __uint_as_float(w.x & 0xffff0000u); f[2] = __uint_as_float(w.y << 16); f[3] = __uint_as_float(w.y & 0xffff0000u);
    f[4] = __uint_as_float(w.z << 16); f[5] = __uint_as_float(w.z & 0xffff0000u); f[6] = __uint_as_float(w.w << 16); f[7] = __uint_as_float(w.w & 0xffff0000u); }

__device__ __forceinline__ void partialSM(f32x16& p0, f32x16& p1, float& m_reg, float& alpha) {
    float pmax = p0[0];
#pragma unroll
    for (int r = 1; r < 16; ++r) pmax = fmaxf(pmax, p0[r]);
#pragma unroll
    for (int r = 0; r < 16; ++r) pmax = fmaxf(pmax, p1[r]);
    { auto rr = __builtin_amdgcn_permlane32_swap(__float_as_uint(pmax), __float_as_uint(pmax), false, false); pmax = fmaxf(__uint_as_float(rr[0]), __uint_as_float(rr[1])); }
    const bool keep = __all(pmax - m_reg <= THR2); const float mx = fmaxf(m_reg, pmax), mn = keep ? m_reg : mx;
    alpha = keep ? 1.f : __builtin_amdgcn_exp2f(m_reg - mx); m_reg = mn;
#pragma unroll
    for (int r = 0; r < 16; ++r) { p0[r] -= mn; p1[r] -= mn; }
#pragma unroll
    for (int r = 0; r < 16; ++r) p0[r] = __builtin_amdgcn_exp2f(p0[r]);
}
__device__ __forceinline__ void finishSM(f32x16& p0, f32x16& p1, float alpha, float& l_reg, bf16x8& pa0, bf16x8& pa1, bf16x8& pa2, bf16x8& pa3) {
#pragma unroll
    for (int r = 0; r < 16; ++r) p1[r] = __builtin_amdgcn_exp2f(p1[r]);
    float ps = 0;
#pragma unroll
    for (int r = 0; r < 16; ++r) ps += p0[r];
#pragma unroll
    for (int r = 0; r < 16; ++r) ps += p1[r];
    { auto rr = __builtin_amdgcn_permlane32_swap(__float_as_uint(ps), __float_as_uint(ps), false, false); ps = __uint_as_float(rr[0]) + __uint_as_float(rr[1]); }
    l_reg = l_reg * alpha + ps;
#define FA_PK4(P, BASE, OUT) do { unsigned a0 = cvtpk(P[BASE + 0], P[BASE + 1]), a1 = cvtpk(P[BASE + 2], P[BASE + 3]);   \
    unsigned b0 = cvtpk(P[BASE + 4], P[BASE + 5]), b1 = cvtpk(P[BASE + 6], P[BASE + 7]);                              \
    auto r0 = __builtin_amdgcn_permlane32_swap(a0, b0, false, false); auto r1 = __builtin_amdgcn_permlane32_swap(a1, b1, false, false); \
    u32x4 w = {r0[0], r1[0], r0[1], r1[1]}; OUT = __builtin_bit_cast(bf16x8, w); } while (0)
    FA_PK4(p0, 0, pa0); FA_PK4(p0, 8, pa1); FA_PK4(p1, 0, pa2); FA_PK4(p1, 8, pa3);
#undef FA_PK4
}
template <int D1, int D2>
__device__ __forceinline__ void qkt(f32x16& p0, f32x16& p1, const char* K1s, const char* K2s, const bf16x8* qr, int r32, int hi) {
    if (FA_SETPRIO) __builtin_amdgcn_s_setprio(1);
#pragma unroll
    for (int d0 = 0; d0 < D1 / 16; ++d0) { const int cb = (d0 * 16 + hi * 8) * 2;
        const bf16x8 b0 = *reinterpret_cast<const bf16x8*>(K1s + FA_KSWZ(r32, cb));
        const bf16x8 b1 = *reinterpret_cast<const bf16x8*>(K1s + FA_KSWZ(32 + r32, cb));
        p0 = __builtin_amdgcn_mfma_f32_32x32x16_bf16(b0, qr[d0], p0, 0, 0, 0);
        p1 = __builtin_amdgcn_mfma_f32_32x32x16_bf16(b1, qr[d0], p1, 0, 0, 0); }
#pragma unroll
    for (int d0 = 0; d0 < D2 / 16; ++d0) { const int ch = 2 * d0 + hi;
        const bf16x8 b0 = *reinterpret_cast<const bf16x8*>(K2s + FA_K2SWZ(r32, ch));
        const bf16x8 b1 = *reinterpret_cast<const bf16x8*>(K2s + FA_K2SWZ(32 + r32, ch));
        p0 = __builtin_amdgcn_mfma_f32_32x32x16_bf16(b0, qr[D1 / 16 + d0], p0, 0, 0, 0);
        p1 = __builtin_amdgcn_mfma_f32_32x32x16_bf16(b1, qr[D1 / 16 + d0], p1, 0, 0, 0); }
    if (FA_SETPRIO) __builtin_amdgcn_s_setprio(0);
}
__device__ __forceinline__ int v_st(int k, int c) { const int kk = (k & ~0xC) | ((k & 4) << 1) | ((k & 8) >> 1); return ((kk >> 3) * 4 + (c >> 5)) * 512 + ((kk & 7) * 32 + (c & 31)) * 2; }
__device__ __forceinline__ int v_rd_base(int lane) { return ((lane & 3) << 3) | (((lane >> 2) & 3) << 6) | (((lane >> 4) & 1) << 5) | (((lane >> 5) & 1) << 8); }
constexpr int v_rd_off(int d0, int ks, int half) { return d0 * 512 + ks * 4096 + half * 2048; }
template <int OFF> __device__ __forceinline__ s16x4 tr_read(int vb) { s16x4 r; asm volatile("ds_read_b64_tr_b16 %0, %1 offset:%2" : "=&v"(r) : "v"(vb), "i"(OFF) : "memory"); return r; }
template <int D0> __device__ __forceinline__ void pv_one(f32x16& od, int vb, bf16x8 pa0, bf16x8 pa1, bf16x8 pa2, bf16x8 pa3) {
    s16x4 l0 = tr_read<v_rd_off(D0, 0, 0)>(vb), h0 = tr_read<v_rd_off(D0, 0, 1)>(vb), l1 = tr_read<v_rd_off(D0, 1, 0)>(vb), h1 = tr_read<v_rd_off(D0, 1, 1)>(vb);
    s16x4 l2 = tr_read<v_rd_off(D0, 2, 0)>(vb), h2 = tr_read<v_rd_off(D0, 2, 1)>(vb), l3 = tr_read<v_rd_off(D0, 3, 0)>(vb), h3 = tr_read<v_rd_off(D0, 3, 1)>(vb);
    if (FA_PVDEP) asm volatile("s_waitcnt lgkmcnt(0)" : "+v"(l0), "+v"(h0), "+v"(l1), "+v"(h1), "+v"(l2), "+v"(h2), "+v"(l3), "+v"(h3) :: "memory");
    else { asm volatile("s_waitcnt lgkmcnt(0)" ::: "memory"); FA_SBAR(); }
    if (FA_SETPRIO) __builtin_amdgcn_s_setprio(1);
#define FA_PK(L, H) (bf16x8){L[0], L[1], L[2], L[3], H[0], H[1], H[2], H[3]}
    od = __builtin_amdgcn_mfma_f32_32x32x16_bf16(pa0, FA_PK(l0, h0), od, 0, 0, 0);
    od = __builtin_amdgcn_mfma_f32_32x32x16_bf16(pa1, FA_PK(l1, h1), od, 0, 0, 0);
    od = __builtin_amdgcn_mfma_f32_32x32x16_bf16(pa2, FA_PK(l2, h2), od, 0, 0, 0);
    od = __builtin_amdgcn_mfma_f32_32x32x16_bf16(pa3, FA_PK(l3, h3), od, 0, 0, 0);
    if (FA_SETPRIO) __builtin_amdgcn_s_setprio(0);
#undef FA_PK
}
__device__ __forceinline__ void pv_d0(f32x16* o, int vb, bf16x8 pa0, bf16x8 pa1, bf16x8 pa2, bf16x8 pa3) {
    pv_one<0>(o[0], vb, pa0, pa1, pa2, pa3); pv_one<1>(o[1], vb, pa0, pa1, pa2, pa3); pv_one<2>(o[2], vb, pa0, pa1, pa2, pa3); pv_one<3>(o[3], vb, pa0, pa1, pa2, pa3);
}

typedef __amdgpu_buffer_rsrc_t rsrc_t;
__device__ __forceinline__ rsrc_t mk_rsrc(const void* p, unsigned bytes) { return __builtin_amdgcn_make_buffer_rsrc((void*)p, 0, (int)bytes, 0x00020000); }
constexpr unsigned OUT_BYTES = (unsigned)MTOK * DM * 4u, WS_BYTES = (unsigned)WS_END;
constexpr unsigned OF_H1 = (unsigned)WS_H1, OF_ATT = (unsigned)WS_ATT, OF_KVM = (unsigned)WS_KVM, OF_KPE = (unsigned)WS_KPE, OF_KG = (unsigned)WS_KG;
typedef int i32x4 __attribute__((ext_vector_type(4)));
__device__ __forceinline__ bf16x8 bload16(rsrc_t r, unsigned voff, unsigned soff) { return __builtin_bit_cast(bf16x8, __builtin_amdgcn_raw_buffer_load_b128(r, voff, soff, 0)); }
template <int D0> __device__ __forceinline__ void pv_rd(int vb, s16x4 (&l)[4], s16x4 (&h)[4]) {
    l[0] = tr_read<v_rd_off(D0, 0, 0)>(vb); h[0] = tr_read<v_rd_off(D0, 0, 1)>(vb); l[1] = tr_read<v_rd_off(D0, 1, 0)>(vb); h[1] = tr_read<v_rd_off(D0, 1, 1)>(vb);
    l[2] = tr_read<v_rd_off(D0, 2, 0)>(vb); h[2] = tr_read<v_rd_off(D0, 2, 1)>(vb); l[3] = tr_read<v_rd_off(D0, 3, 0)>(vb); h[3] = tr_read<v_rd_off(D0, 3, 1)>(vb);
}
__device__ __forceinline__ void pv_mm(f32x16& od, const s16x4 (&l)[4], const s16x4 (&h)[4], bf16x8 pa0, bf16x8 pa1, bf16x8 pa2, bf16x8 pa3) {
#define FA_PK(L, H) (bf16x8){L[0], L[1], L[2], L[3], H[0], H[1], H[2], H[3]}
    od = __builtin_amdgcn_mfma_f32_32x32x16_bf16(pa0, FA_PK(l[0], h[0]), od, 0, 0, 0);
    od = __builtin_amdgcn_mfma_f32_32x32x16_bf16(pa1, FA_PK(l[1], h[1]), od, 0, 0, 0);
    od = __builtin_amdgcn_mfma_f32_32x32x16_bf16(pa2, FA_PK(l[2], h[2]), od, 0, 0, 0);
    od = __builtin_amdgcn_mfma_f32_32x32x16_bf16(pa3, FA_PK(l[3], h[3]), od, 0, 0, 0);
#undef FA_PK
}
__device__ __forceinline__ void pv_d0p(f32x16* o, int vb, bf16x8 pa0, bf16x8 pa1, bf16x8 pa2, bf16x8 pa3) {
    s16x4 la[4], ha[4], lb[4], hb[4];
    pv_rd<0>(vb, la, ha); pv_rd<1>(vb, lb, hb);
    asm volatile("s_waitcnt lgkmcnt(8)" ::: "memory"); FA_SBAR(); pv_mm(o[0], la, ha, pa0, pa1, pa2, pa3); FA_SBAR();
    pv_rd<2>(vb, la, ha);
    asm volatile("s_waitcnt lgkmcnt(8)" ::: "memory"); FA_SBAR(); pv_mm(o[1], lb, hb, pa0, pa1, pa2, pa3); FA_SBAR();
    pv_rd<3>(vb, lb, hb);
    asm volatile("s_waitcnt lgkmcnt(8)" ::: "memory"); FA_SBAR(); pv_mm(o[2], la, ha, pa0, pa1, pa2, pa3); FA_SBAR();
    asm volatile("s_waitcnt lgkmcnt(0)" ::: "memory"); FA_SBAR(); pv_mm(o[3], lb, hb, pa0, pa1, pa2, pa3);
}

struct CoreP {
    rsrc_t K1; unsigned oK1;
    rsrc_t K2; unsigned oK2;
    rsrc_t V; unsigned oV;
    int NT;
    float slope2; int qrel0;
    int R0, rlo;
};
template <int MODE, int D1, int D2, int LDK1, int LDK2, int LDV, bool PVP = false>
__device__ __forceinline__ void attn_core_r(const bf16x8* qr, const CoreP& P, f32x16 (&o)[4], float& l_reg, char* lds) {
    const int tid = fresh_tid(), lane = tid & 63, wid = __builtin_amdgcn_readfirstlane(tid >> 6), r32 = lane & 31, hi = lane >> 5;
    char* V_lds = lds + R_V; char* K1_lds = lds + R_K1; char* K2_lds = lds + R_K2;
    float* wsf = (float*)(lds + L_WS) + wid * 64; float* al_l = wsf + 32;
    float m_reg = -1e30f; l_reg = 0.f;
#pragma unroll
    for (int d = 0; d < 4; ++d) o[d] = f32x16{};
    const int sr = tid >> 4, sc = (tid & 15) * 8, vst0 = v_st(sr, sc), vst1 = v_st(32 + sr, sc), k2r = tid >> 3, k2c = tid & 7;
    struct { bf16x8 vs0, vs1, ka0, ka1, kb; } st;
    const unsigned voffV = (unsigned)((sr * LDV + sc) * 2), voffK1 = (unsigned)((sr * LDK1 + sc) * 2), voffK2 = (unsigned)((k2r * LDK2 + k2c * 8) * 2);
#define FR_SLOAD(k0) do { const unsigned vo_ = P.oV + (unsigned)(k0) * (LDV * 2); st.vs0 = bload16(P.V, voffV, vo_); st.vs1 = bload16(P.V, voffV, vo_ + 32 * LDV * 2); \
    if constexpr (D1 > 0) { const unsigned ko_ = P.oK1 + (unsigned)(k0) * (LDK1 * 2); st.ka0 = bload16(P.K1, voffK1, ko_); st.ka1 = bload16(P.K1, voffK1, ko_ + 32 * LDK1 * 2); } \
    if constexpr (D2 > 0) { st.kb = bload16(P.K2, voffK2, P.oK2 + (unsigned)(k0) * (LDK2 * 2)); } } while (0)
#define FR_SWRITE(sl) do { *(bf16x8*)(V_lds + (sl) * SHM_V + vst0) = st.vs0; *(bf16x8*)(V_lds + (sl) * SHM_V + vst1) = st.vs1; \
    if constexpr (D1 > 0) { *(bf16x8*)(K1_lds + (sl) * SHM_K1 + FA_KSWZ(sr, sc * 2)) = st.ka0; *(bf16x8*)(K1_lds + (sl) * SHM_K1 + FA_KSWZ(32 + sr, sc * 2)) = st.ka1; } \
    if constexpr (D2 > 0) { *(bf16x8*)(K2_lds + (sl) * SHM_K2 + FA_K2SWZ(k2r, k2c)) = st.kb; } } while (0)
#define FR_RESC(a) do { if (__any((a) < 1.f)) { if (hi == 0) al_l[r32] = (a); asm volatile("s_waitcnt lgkmcnt(0)" ::: "memory"); \
    _Pragma("unroll") for (int d = 0; d < 4; ++d) _Pragma("unroll") for (int r = 0; r < 16; ++r) o[d][r] *= al_l[crow(r, hi)]; } } while (0)
    const int qw = P.qrel0 + wid * 32, qrel = qw + r32;
    const unsigned lm0 = hi ? 0u : 0xffffffffu;
    const float s_hi_f = __uint_as_float(cvtpk_c(P.slope2, 0.f) << 16), s_lo_f = P.slope2 - s_hi_f;
    const unsigned ws_pk = cvtpk_c(s_hi_f, s_lo_f);
    bf16x8 ab0, ab1;
    { const unsigned kk0_ = cvtpk_c((float)r32, (float)r32), kk1_ = cvtpk_c((float)(32 + r32), (float)(32 + r32)), s256_ = cvtpk_c(256.f * s_hi_f, 256.f * s_lo_f);
      const u32x4 a0_ = {kk0_ & lm0, s256_ & lm0, ws_pk & lm0, 0u}, a1_ = {kk1_ & lm0, s256_ & lm0, ws_pk & lm0, 0u}; ab0 = __builtin_bit_cast(bf16x8, a0_); ab1 = __builtin_bit_cast(bf16x8, a1_); }
    const int na_rq = P.R0 + (wid >> 1), na_lo = min(max(na_rq - 4, 0), 56) - P.rlo;
#define FR_INB(t) true
  \
  \
#define FR_BIAS(P0, P1, t) do { if constexpr (MODE == 0) { const int k0_ = (t) * 64; \
    if (FA_MBIAS && (k0_ + 63 <= qw || k0_ >= qw + 31)) { const bool left_ = (k0_ + 63 <= qw); const int d_ = qrel - k0_; \
        float na_ = (float)(d_ >> 8), nb_ = (float)(d_ & 255); if (left_) { na_ = -na_; nb_ = -nb_; } \
        const unsigned w0_ = left_ ? ws_pk : (ws_pk ^ 0x80008000u), w1_ = cvtpk_c(na_, na_), w2_ = cvtpk_c(nb_, nb_); \
        const u32x4 bw_ = {w0_ & lm0, w1_ & lm0, w2_ & lm0, 0u}; const bf16x8 bb_ = __builtin_bit_cast(bf16x8, bw_); \
        P0 = __builtin_amdgcn_mfma_f32_32x32x16_bf16(ab0, bb_, f32x16{}, 0, 0, 0); P1 = __builtin_amdgcn_mfma_f32_32x32x16_bf16(ab1, bb_, f32x16{}, 0, 0, 0); } \
    else { float fb = (float)((t) * 64 + 4 * hi - qrel); asm volatile("" : "+v"(fb)); \
        _Pragma("unroll") for (int r = 0; r < 16; ++r) { const float c = (float)((r & 3) + 8 * (r >> 2)); P0[r] = -P.slope2 * fabsf(fb + c); P1[r] = -P.slope2 * fabsf(fb + 32.f + c); } } } } while (0)
#define FR_QKT(P0, P1, sl, t) do { \
    if constexpr (MODE != 0) { P0 = f32x16{}; P1 = f32x16{}; } \
    qkt<D1, D2>(P0, P1, K1_lds + (sl) * SHM_K1, K2_lds + (sl) * SHM_K2, qr, r32, hi); \
    if constexpr (MODE == 3) { const int kr = P.rlo + (t); int l3 = lane; asm volatile("" : "+v"(l3)); \
        const int hi3 = l3 >> 5, cq3 = (wid & 1) * 32 + (l3 & 31), c03 = min(max(cq3 - 8, 0), 48); \
        if ((t) < na_lo || (t) >= na_lo + 8) { _Pragma("unroll") for (int r = 0; r < 16; ++r) { P0[r] = -INFINITY; P1[r] = -INFINITY; } } \
        else { const float* rp = (const float*)(lds + L_RPB) + 64 + (kr - na_rq + 7) * 32 - cq3 + 15 + 4 * hi3; const int tb = 4 * hi3 - c03; \
        _Pragma("unroll") for (int r = 0; r < 16; ++r) { const int cr = (r & 3) + 8 * (r >> 2); \
            P0[r] = ((unsigned)(tb + cr) < 16u) ? P0[r] + rp[cr] : -INFINITY; P1[r] = ((unsigned)(tb + cr + 32) < 16u) ? P1[r] + rp[cr + 32] : -INFINITY; } } } \
    } while (0)
    f32x16 pA0, pA1, pB0, pB1; float alA = 1.f, alB = 1.f; bf16x8 pa0, pa1, pa2, pa3; const int NT = P.NT;
    int s_prev = 0, s_cur = 1, s_next = 2;
#define FR_HALF(t, X0, X1, ALX, Y0, Y1, ALY) do { \
    FA_ALIGN(); FA_SBAR(); if (FR_INB(t)) FR_QKT(X0, X1, s_cur, t); \
    if (FR_INB((t) - 1)) finishSM(Y0, Y1, ALY, l_reg, pa0, pa1, pa2, pa3); if (!(FA_NOSB & 1)) FA_SBAR(); \
    if ((t) + 1 < NT) { FR_SWRITE(s_next); if ((t) + 2 < NT) FR_SLOAD(((t) + 2) * 64); } if (!(FA_NOSB & 2)) FA_SBAR(); \
    FR_BIAS(Y0, Y1, (t) + 1); \
    if (FR_INB((t) - 1)) { if constexpr (PVP) pv_d0p(o, vb0 + s_prev * SHM_V, pa0, pa1, pa2, pa3); else pv_d0(o, vb0 + s_prev * SHM_V, pa0, pa1, pa2, pa3); } \
    if (FR_INB(t)) { partialSM(X0, X1, m_reg, ALX); FR_RESC(ALX); } \
    __syncthreads(); { const int s_ = s_prev; s_prev = s_cur; s_cur = s_next; s_next = s_; } } while (0)
#define FR_TAIL(Y0, Y1, ALY) do { if (FR_INB(NT - 1)) { finishSM(Y0, Y1, ALY, l_reg, pa0, pa1, pa2, pa3); FA_SBAR(); const int vb0 = (int)(uintptr_t)V_lds + v_rd_base(fresh_tid() & 63);     if constexpr (PVP) pv_d0p(o, vb0 + s_prev * SHM_V, pa0, pa1, pa2, pa3); else pv_d0(o, vb0 + s_prev * SHM_V, pa0, pa1, pa2, pa3); } } while (0)
    FR_SLOAD(0); FR_SWRITE(0);
    if (NT > 1) { FR_SLOAD(64); FR_SWRITE(1); }
    __syncthreads();
    FR_BIAS(pA0, pA1, 0);
    if (FR_INB(0)) { FR_QKT(pA0, pA1, 0, 0); partialSM(pA0, pA1, m_reg, alA); }
    FR_BIAS(pB0, pB1, 1);
    if (NT > 2) FR_SLOAD(128);
    const int vb0 = (int)(uintptr_t)V_lds + v_rd_base(fresh_tid() & 63);
    int t = 1;
#pragma clang loop unroll(disable)
    for (; t + 1 < NT; t += 2) { FR_HALF(t, pB0, pB1, alB, pA0, pA1, alA); FR_HALF(t + 1, pA0, pA1, alA, pB0, pB1, alB); }
    if (t < NT) { FR_HALF(t, pB0, pB1, alB, pA0, pA1, alA); FR_TAIL(pB0, pB1, alB); }
    else { { const int s_ = s_prev; (void)s_; } FR_TAIL(pA0, pA1, alA); }
    asm volatile("s_waitcnt vmcnt(0) lgkmcnt(0)" ::: "memory"); __syncthreads();
#undef FR_SLOAD
#undef FR_SWRITE
#undef FR_RESC
#undef FR_INB
#undef FR_QKT
#undef FR_BIAS
#undef FR_HALF
#undef FR_TAIL
}
__device__ __forceinline__ void row_inv(float l_reg, float* rli, char* lds, int wid, int r32, int hi) {
    float* li_l = (float*)(lds + L_WS) + wid * 64;
    if (hi == 0) li_l[r32] = l_reg; asm volatile("s_waitcnt lgkmcnt(0)" ::: "memory");
#pragma unroll
    for (int r = 0; r < 16; ++r) rli[r] = __builtin_amdgcn_rcpf(li_l[crow(r, hi)]);
}
__device__ __forceinline__ float silu_f(float x) { return x * __builtin_amdgcn_rcpf(1.0f + __builtin_amdgcn_exp2f(-1.4426950408889634f * x)); }
__device__ __forceinline__ float bfv(bf16 u) { return __uint_as_float((unsigned)u << 16); }
__device__ __forceinline__ bf16 f2b(float f) { unsigned u = __builtin_bit_cast(unsigned, f); return (bf16)((u + 0x7fffu + ((u >> 16) & 1u)) >> 16); }

template <int NQ> __device__ __forceinline__ float unit_qmax2(const bf16x8* qr, char* lds, int wid) {
    float ss = 0.f;
#pragma unroll
    for (int d0 = 0; d0 < NQ; ++d0) { float f[8]; unpack8(qr[d0], f);
#pragma unroll
        for (int j = 0; j < 8; ++j) ss = fmaf(f[j], f[j], ss); }
    { auto rr = __builtin_amdgcn_permlane32_swap(__float_as_uint(ss), __float_as_uint(ss), false, false); ss = __uint_as_float(rr[0]) + __uint_as_float(rr[1]); }
    ss = fmaxf(ss, swz_xor<1>(ss)); ss = fmaxf(ss, swz_xor<2>(ss)); ss = fmaxf(ss, swz_xor<4>(ss)); ss = fmaxf(ss, swz_xor<8>(ss)); ss = fmaxf(ss, swz_xor<16>(ss));
    float* qm = (float*)(lds + L_QMAX);
    qm[wid] = ss; asm volatile("s_waitcnt lgkmcnt(0)" ::: "memory"); __syncthreads();
    float m = qm[0];
#pragma unroll
    for (int w = 1; w < 8; ++w) m = fmaxf(m, qm[w]);
    return m;
}
constexpr int KM_DIFF = 0, KM_WORDS = 64;
struct Ptrs { const bf16* H1; const bf16* QM; const bf16* KVM; const bf16* KPE; const bf16* KG; bf16* ATT; const f32x2* TAB; const float* consts; const float* subln; const float* qnorm; const float* rpb; float* dscr; const unsigned* kmax; const unsigned char* ws; };

constexpr int STG_PITCH = 272, STG_WAVE = 32 * STG_PITCH;
template <int LDG, int LDO, bool SEG2 = false>
__device__ __forceinline__ void store_gated(const f32x16 (&o)[4], const float* rli, rsrc_t G, unsigned gB, unsigned oB, char* lds) { const rsrc_t O = G;
    const int tid = fresh_tid(), lane = tid & 63, wid = __builtin_amdgcn_readfirstlane(tid >> 6), r32 = lane & 31, hi = lane >> 5;
    char* stg = lds + wid * STG_WAVE;
#pragma unroll
    for (int r = 0; r < 16; ++r)
#pragma unroll
        for (int d0 = 0; d0 < 4; ++d0) { const float v_ = o[d0][r] * rli[r]; *(bf16*)(stg + crow(r, hi) * STG_PITCH + (d0 * 32 + r32) * 2) = (bf16)cvtpk(v_, v_); }
    const int rl = lane >> 4, ch = lane & 15;
    const unsigned vG = gB + (unsigned)((rl * LDG + ch * 8) * 2), vO = oB + (unsigned)((rl * LDO + ch * 8) * 2);
    u32x4 gv[8];
#pragma unroll
    for (int i = 0; i < 8; ++i) gv[i] = __builtin_bit_cast(u32x4, __builtin_amdgcn_raw_buffer_load_b128(G, vG, ((4 * i + ((SEG2 && i >= 4) ? 48 : 0)) * LDG) * 2, 0));
    asm volatile("s_waitcnt lgkmcnt(0)" ::: "memory");
#pragma unroll
    for (int i = 0; i < 8; ++i) { const u32x4 ov = *(const u32x4*)(stg + (4 * i + rl) * STG_PITCH + ch * 16); u32x4 w;
#pragma unroll
        for (int e = 0; e < 4; ++e) { const float a0 = __uint_as_float(ov[e] << 16), a1 = __uint_as_float(ov[e] & 0xffff0000u), g0 = __uint_as_float(gv[i][e] << 16), g1 = __uint_as_float(gv[i][e] & 0xffff0000u);
            w[e] = cvtpk(a0 * silu_f(g0), a1 * silu_f(g1)); }
        __builtin_amdgcn_raw_buffer_store_b128(__builtin_bit_cast(i32x4, w), O, vO, ((4 * i + ((SEG2 && i >= 4) ? 48 : 0)) * LDO) * 2, 0); }
    __syncthreads();
}

__device__ __forceinline__ void unit_diff(const Ptrs& A, int b, int h, int qb, char* lds) {
    int tid = fresh_tid(), lane = tid & 63, wid = __builtin_amdgcn_readfirstlane(tid >> 6), r32 = lane & 31, hi = lane >> 5; long row0 = (long)b * SEQ + qb * 256 + wid * 32;
    const rsrc_t DSr = mk_rsrc(A.dscr, OUT_BYTES); unsigned voffD = 0;
    f32x16 o[4]; float l_reg; float rli[16];
#pragma clang loop unroll(disable)
    for (int mp = 0; mp < 2; ++mp) {
        bf16x8 qr[4]; const bf16* qp = A.H1 + (row0 + r32) * NIN + E_QA + h * 128 + mp * 64 + hi * 8;
#pragma unroll
        for (int d0 = 0; d0 < 4; ++d0) qr[d0] = *(const bf16x8*)(qp + d0 * 16);
        CoreP P; P.K1 = mk_rsrc(A.ws, WS_BYTES); P.oK1 = 0; P.K2 = P.K1; P.oK2 = OF_H1 + (unsigned)((b * SEQ * NIN + E_KA + h * 128 + mp * 64) * 2); P.V = P.K1; P.oV = OF_H1 + (unsigned)((b * SEQ * NIN + E_VA + h * 128) * 2);
        P.slope2 = exp2f(-(float)(h + 1)) * LOG2E; P.R0 = 0; P.rlo = 0;
        { const float q2 = unit_qmax2<4>(qr, lds, wid), k2 = __uint_as_float(__hip_atomic_load(A.kmax + KM_DIFF + (b * 8 + h) * 2 + mp, __ATOMIC_RELAXED, __HIP_MEMORY_SCOPE_AGENT));
          const float B = sqrtf(q2 * k2); float dsk = (B < 1e4f) ? (2.f * B + 40.f) / P.slope2 : 1e6f; dsk = fminf(dsk, 1e6f);
          const int q0 = qb * 256; int lo = max((int)floorf(((float)q0 - dsk) * (1.f / 64)), 0), hi_t = min((int)floorf(((float)(q0 + 255) + dsk) * (1.f / 64)), 63);
          lo = __builtin_amdgcn_readfirstlane(lo); hi_t = __builtin_amdgcn_readfirstlane(hi_t);
          P.NT = hi_t - lo + 1; P.qrel0 = q0 - lo * 64; P.oK2 += (unsigned)(lo * 64 * NIN * 2); P.oV += (unsigned)(lo * 64 * NIN * 2); }
        attn_core_r<0, 0, 64, 8, NIN, NIN, (FA_PVP & 1) != 0>(qr, P, o, l_reg, lds);
        tid = fresh_tid(); lane = tid & 63; wid = __builtin_amdgcn_readfirstlane(tid >> 6); r32 = lane & 31; hi = lane >> 5;
        row0 = (long)b * SEQ + qb * 256 + wid * 32; voffD = (unsigned)(((int)blockIdx.x * 32768 + (wid * 32 + 4 * hi) * 128 + r32) * 4);
        row_inv(l_reg, rli, lds, wid, r32, hi);
        if (mp == 0) {
#pragma unroll
            for (int r = 0; r < 16; ++r)
#pragma unroll
                for (int d0 = 0; d0 < 4; ++d0) __builtin_amdgcn_raw_buffer_store_b32(__float_as_uint(o[d0][r] * rli[r]), DSr, voffD, (((r & 3) + 8 * (r >> 2)) * 128 + d0 * 32) * 4, 0);
        }
    }
    const float lam = A.consts[0];
    float ssq[16];
    { unsigned o0w[16][4];
#pragma unroll
      for (int r = 0; r < 16; ++r)
#pragma unroll
          for (int d0 = 0; d0 < 4; ++d0) o0w[r][d0] = __builtin_amdgcn_raw_buffer_load_b32(DSr, voffD, (((r & 3) + 8 * (r >> 2)) * 128 + d0 * 32) * 4, 16);
      asm volatile("" ::: "memory");
#pragma unroll
      for (int r = 0; r < 16; ++r) { float s = 0.f;
#pragma unroll
          for (int d0 = 0; d0 < 4; ++d0) { const float e = __uint_as_float(o0w[r][d0]) - lam * (o[d0][r] * rli[r]); o[d0][r] = e; s += e * e; }
          ssq[r] = s; } }
#pragma unroll
    for (int r = 0; r < 16; ++r) {
        ssq[r] += swz_xor<1>(ssq[r]); ssq[r] += swz_xor<2>(ssq[r]); ssq[r] += swz_xor<4>(ssq[r]); ssq[r] += swz_xor<8>(ssq[r]); ssq[r] += swz_xor<16>(ssq[r]);
        ssq[r] = 0.8f / sqrtf(ssq[r] * (1.f / 128) + EPS); }
    float sg[4];
#pragma unroll
    for (int d0 = 0; d0 < 4; ++d0) sg[d0] = A.subln[d0 * 32 + r32];
#pragma unroll
    for (int r = 0; r < 16; ++r)
#pragma unroll
        for (int d0 = 0; d0 < 4; ++d0) o[d0][r] *= sg[d0];
    store_gated<NIN, DM>(o, ssq, mk_rsrc(A.ws, WS_BYTES), OF_H1 + (unsigned)((row0 * NIN + E_GA + h * 128) * 2), OF_ATT + (unsigned)((row0 * DM + h * 128) * 2), lds);
}
__device__ __forceinline__ void unit_mla(const Ptrs& A, int b, int h, int qb, char* lds) {
    int tid = fresh_tid(), lane = tid & 63, wid = __builtin_amdgcn_readfirstlane(tid >> 6), r32 = lane & 31, hi = lane >> 5; long row0 = (long)b * SEQ + qb * 256 + wid * 32; const int tq = qb * 256 + wid * 32 + r32;
    bf16x8 qr[12]; const bf16* qp = A.QM + (row0 + r32) * QMW + h * 192 + hi * 8;
#pragma unroll
    for (int d0 = 0; d0 < 8; ++d0) qr[d0] = *(const bf16x8*)(qp + d0 * 16);
#pragma unroll
    for (int d0 = 8; d0 < 12; ++d0) { float f[8]; unpack8(*(const bf16x8*)(qp + d0 * 16), f); const f32x2* tp = A.TAB + tq * 32 + 8 * (d0 - 8) + 4 * hi;
#pragma unroll
        for (int jj = 0; jj < 4; ++jj) { const f32x2 cs = tp[jj]; const float x1 = f[2 * jj], x2 = f[2 * jj + 1]; f[2 * jj] = x1 * cs.x - x2 * cs.y; f[2 * jj + 1] = x1 * cs.y + x2 * cs.x; }
        qr[d0] = pack8(f); }
    CoreP P; P.K1 = mk_rsrc(A.ws, WS_BYTES); P.oK1 = OF_KVM + (unsigned)((b * SEQ * KVW + h * 256) * 2); P.K2 = P.K1; P.oK2 = OF_KPE + (unsigned)(b * SEQ * 64 * 2); P.V = P.K1; P.oV = P.oK1 + 256;
    P.NT = SEQ / 64; P.slope2 = 0.f; P.qrel0 = 0; P.R0 = 0; P.rlo = 0;
    f32x16 o[4]; float l_reg; float rli[16];
    attn_core_r<1, 128, 64, KVW, 64, KVW, (FA_PVP & 2) != 0>(qr, P, o, l_reg, lds);
    tid = fresh_tid(); lane = tid & 63; wid = __builtin_amdgcn_readfirstlane(tid >> 6); r32 = lane & 31; hi = lane >> 5;
    row0 = (long)b * SEQ + qb * 256 + wid * 32;
    row_inv(l_reg, rli, lds, wid, r32, hi);
    store_gated<NIN, DM>(o, rli, mk_rsrc(A.ws, WS_BYTES), OF_H1 + (unsigned)((row0 * NIN + E_GB + h * 128) * 2), OF_ATT + (unsigned)((row0 * DM + 1024 + h * 128) * 2), lds);
}
__device__ __forceinline__ void unit_gqa(const Ptrs& A, int b, int h, int qb, char* lds) {
    int tid = fresh_tid(), lane = tid & 63, wid = __builtin_amdgcn_readfirstlane(tid >> 6), r32 = lane & 31, hi = lane >> 5; long row0 = (long)b * SEQ + qb * 256 + wid * 32; const int tq = qb * 256 + wid * 32 + r32;
    bf16x8 qr[8];
    { float f[8][8]; const bf16* qp = A.H1 + (row0 + r32) * NIN + O_QD + h * 128 + hi * 8; float ss = 0.f;
#pragma unroll
      for (int d0 = 0; d0 < 8; ++d0) { unpack8(*(const bf16x8*)(qp + d0 * 16), f[d0]);
#pragma unroll
          for (int j = 0; j < 8; ++j) ss = fmaf(f[d0][j], f[d0][j], ss); }
      { auto rr = __builtin_amdgcn_permlane32_swap(__float_as_uint(ss), __float_as_uint(ss), false, false); ss = __uint_as_float(rr[0]) + __uint_as_float(rr[1]); }
      const float rstd = 1.0f / sqrtf(ss * (1.f / 128) + EPS);
#pragma unroll
      for (int d0 = 0; d0 < 8; ++d0)
#pragma unroll
          for (int j = 0; j < 8; ++j) f[d0][j] *= rstd * A.qnorm[d0 * 16 + hi * 8 + j];
      const float qs = 0.08838834764831845f * LOG2E;
#pragma unroll
      for (int half = 0; half < 2; ++half) { const int pos = half ? (tq & 63) : (tq >> 6);
#pragma unroll
          for (int dd = 0; dd < 2; ++dd) { const int d0 = 4 * half + dd; const f32x2* tp = A.TAB + pos * 32 + 16 * dd + 8 * hi;
#pragma unroll
              for (int j = 0; j < 8; ++j) { const f32x2 cs = tp[j]; const float x1 = f[d0][j], x2 = f[d0 + 2][j]; f[d0][j] = (x1 * cs.x - x2 * cs.y) * qs; f[d0 + 2][j] = (x1 * cs.y + x2 * cs.x) * qs; } } }
#pragma unroll
      for (int d0 = 0; d0 < 8; ++d0) qr[d0] = pack8(f[d0]); }
    const int kvh = h >> 2;
    CoreP P; P.K1 = mk_rsrc(A.ws, WS_BYTES); P.oK1 = OF_KG + (unsigned)((b * SEQ * 256 + kvh * 128) * 2); P.K2 = P.K1; P.oK2 = 0; P.V = P.K1; P.oV = OF_H1 + (unsigned)((b * SEQ * NIN + O_VD + kvh * 128) * 2);
    P.NT = SEQ / 64; P.slope2 = 0.f; P.qrel0 = 0; P.R0 = 0; P.rlo = 0;
    f32x16 o[4]; float l_reg; float rli[16];
    attn_core_r<2, 128, 0, 256, 8, NIN, (FA_PVP & 4) != 0>(qr, P, o, l_reg, lds);
    tid = fresh_tid(); lane = tid & 63; wid = __builtin_amdgcn_readfirstlane(tid >> 6); r32 = lane & 31; hi = lane >> 5;
    row0 = (long)b * SEQ + qb * 256 + wid * 32;
    row_inv(l_reg, rli, lds, wid, r32, hi);
    store_gated<NIN, DM>(o, rli, mk_rsrc(A.ws, WS_BYTES), OF_H1 + (unsigned)((row0 * NIN + O_GD + h * 128) * 2), OF_ATT + (unsigned)((row0 * DM + 1024 + h * 128) * 2), lds);
}
__device__ __forceinline__ void partialSM1(f32x16& p0, float& m_reg, float& alpha) {
    float pmax = p0[0];
#pragma unroll
    for (int r = 1; r < 16; ++r) pmax = fmaxf(pmax, p0[r]);
    { auto rr = __builtin_amdgcn_permlane32_swap(__float_as_uint(pmax), __float_as_uint(pmax), false, false); pmax = fmaxf(__uint_as_float(rr[0]), __uint_as_float(rr[1])); }
    float mn;
    if (__builtin_expect(__all(pmax - m_reg <= THR2), 1)) { mn = m_reg; alpha = 1.f; }
    else { mn = fmaxf(m_reg, pmax); alpha = __builtin_amdgcn_exp2f(m_reg - mn); m_reg = mn; }
#pragma unroll
    for (int r = 0; r < 16; ++r) p0[r] -= mn;
#pragma unroll
    for (int r = 0; r < 8; ++r) p0[r] = __builtin_amdgcn_exp2f(p0[r]);
}
__device__ __forceinline__ void finishSM1(f32x16& p0, float alpha, float& l_reg, bf16x8& pa0, bf16x8& pa1) {
#pragma unroll
    for (int r = 8; r < 16; ++r) p0[r] = __builtin_amdgcn_exp2f(p0[r]);
    float ps = 0;
#pragma unroll
    for (int r = 0; r < 16; ++r) ps += p0[r];
    { auto rr = __builtin_amdgcn_permlane32_swap(__float_as_uint(ps), __float_as_uint(ps), false, false); ps = __uint_as_float(rr[0]) + __uint_as_float(rr[1]); }
    l_reg = l_reg * alpha + ps;
#define FA_PK4(P, BASE, OUT) do { unsigned a0 = cvtpk(P[BASE + 0], P[BASE + 1]), a1 = cvtpk(P[BASE + 2], P[BASE + 3]);   \
    unsigned b0 = cvtpk(P[BASE + 4], P[BASE + 5]), b1 = cvtpk(P[BASE + 6], P[BASE + 7]);                              \
    auto r0 = __builtin_amdgcn_permlane32_swap(a0, b0, false, false); auto r1 = __builtin_amdgcn_permlane32_swap(a1, b1, false, false); \
    u32x4 w = {r0[0], r1[0], r0[1], r1[1]}; OUT = __builtin_bit_cast(bf16x8, w); } while (0)
    FA_PK4(p0, 0, pa0); FA_PK4(p0, 8, pa1);
#undef FA_PK4
}
template <int D0> __device__ __forceinline__ void pv_na_pair(f32x16* o, int vb, bf16x8 pa0, bf16x8 pa1) {
    const s16x4 l0 = tr_read<v_rd_off(D0, 0, 0)>(vb), h0 = tr_read<v_rd_off(D0, 0, 1)>(vb), l1 = tr_read<v_rd_off(D0, 1, 0)>(vb), h1 = tr_read<v_rd_off(D0, 1, 1)>(vb);
    const s16x4 l2 = tr_read<v_rd_off(D0 + 1, 0, 0)>(vb), h2 = tr_read<v_rd_off(D0 + 1, 0, 1)>(vb), l3 = tr_read<v_rd_off(D0 + 1, 1, 0)>(vb), h3 = tr_read<v_rd_off(D0 + 1, 1, 1)>(vb);
    asm volatile("s_waitcnt lgkmcnt(0)" ::: "memory"); FA_SBAR();
#define FA_PK(L, H) (bf16x8){L[0], L[1], L[2], L[3], H[0], H[1], H[2], H[3]}
    o[D0] = __builtin_amdgcn_mfma_f32_32x32x16_bf16(pa0, FA_PK(l0, h0), o[D0], 0, 0, 0);
    o[D0 + 1] = __builtin_amdgcn_mfma_f32_32x32x16_bf16(pa0, FA_PK(l2, h2), o[D0 + 1], 0, 0, 0);
    o[D0] = __builtin_amdgcn_mfma_f32_32x32x16_bf16(pa1, FA_PK(l1, h1), o[D0], 0, 0, 0);
    o[D0 + 1] = __builtin_amdgcn_mfma_f32_32x32x16_bf16(pa1, FA_PK(l3, h3), o[D0 + 1], 0, 0, 0);
#undef FA_PK
}
template <int LDK1, int LDV>
__device__ __forceinline__ void attn_core_na(const bf16x8* qr, const CoreP& P, f32x16 (&o)[4], float& l_reg, char* lds) {
    const int tid = fresh_tid(), lane = tid & 63, wid = __builtin_amdgcn_readfirstlane(tid >> 6), r32 = lane & 31, hi = lane >> 5;
    char* V_lds = lds + R_V; char* K1_lds = lds + R_K1;
    float* wsf = (float*)(lds + L_WS) + wid * 64; float* al_l = wsf + 32;
    float m_reg = -1e30f; l_reg = 0.f;
#pragma unroll
    for (int d = 0; d < 4; ++d) o[d] = f32x16{};
    const int sr = tid >> 4, sc = (tid & 15) * 8, vst0 = v_st(sr, sc), vst1 = v_st(32 + sr, sc);
    struct { bf16x8 vs0, vs1, ka0, ka1; } st;
    const unsigned voffV = (unsigned)((sr * LDV + sc) * 2), voffK1 = (unsigned)((sr * LDK1 + sc) * 2);
#define FR_SLOAD(k0) do { const unsigned vo_ = P.oV + (unsigned)(k0) * (LDV * 2); st.vs0 = bload16(P.V, voffV, vo_); st.vs1 = bload16(P.V, voffV, vo_ + 32 * LDV * 2); \
    const unsigned ko_ = P.oK1 + (unsigned)(k0) * (LDK1 * 2); st.ka0 = bload16(P.K1, voffK1, ko_); st.ka1 = bload16(P.K1, voffK1, ko_ + 32 * LDK1 * 2); } while (0)
#define FR_SWRITE(sl) do { *(bf16x8*)(V_lds + (sl) * SHM_V + vst0) = st.vs0; *(bf16x8*)(V_lds + (sl) * SHM_V + vst1) = st.vs1; \
    *(bf16x8*)(K1_lds + (sl) * SHM_K1 + FA_KSWZ(sr, sc * 2)) = st.ka0; *(bf16x8*)(K1_lds + (sl) * SHM_K1 + FA_KSWZ(32 + sr, sc * 2)) = st.ka1; } while (0)
#define FR_RESC(a) do { if (__any((a) < 1.f)) { if (hi == 0) al_l[r32] = (a); asm volatile("s_waitcnt lgkmcnt(0)" ::: "memory"); \
    _Pragma("unroll") for (int d = 0; d < 4; ++d) _Pragma("unroll") for (int r = 0; r < 16; ++r) o[d][r] *= al_l[crow(r, hi)]; } } while (0)
    const int cbk = wid & 3, m8 = cbk + (cbk >> 1), kb0 = 8 * m8;
    const int rq0 = P.R0 + 2 * (wid >> 2);
#define FR_QKT(P0, sl, t) do { P0 = f32x16{}; { const char* K1s = K1_lds + (sl) * SHM_K1; \
        _Pragma("unroll") for (int d0 = 0; d0 < 8; ++d0) { const int cb = (d0 * 16 + hi * 8) * 2; \
            const bf16x8 b0 = *reinterpret_cast<const bf16x8*>(K1s + FA_KSWZ(kb0 + r32, cb)); P0 = __builtin_amdgcn_mfma_f32_32x32x16_bf16(b0, qr[d0], P0, 0, 0, 0); } } \
    { const int kr = P.rlo + (t); int l3 = lane; asm volatile("" : "+v"(l3)); \
      const int hi3 = l3 >> 5, rq3 = rq0 + ((l3 >> 4) & 1), cq3 = cbk * 16 + (l3 & 15), c03 = min(max(cq3 - 8, 0), 48), rl3 = min(max(rq3 - 4, 0), 56); \
      const bool rowok = (unsigned)(kr - rl3) < 8u; const int dr = min(max(kr - rq3 + 7, 0), 14); \
      const float* rp = (const float*)(lds + L_RPB) + 64 + dr * 32 - cq3 + 15 + kb0 + 4 * hi3; const int tb = kb0 + 4 * hi3 - c03; \
      _Pragma("unroll") for (int r = 0; r < 16; ++r) { const int cr = (r & 3) + 8 * (r >> 2); \
          P0[r] = (rowok && (unsigned)(tb + cr) < 16u) ? P0[r] + rp[cr] : -INFINITY; } } \
    } while (0)
    f32x16 pA, pB; float alA = 1.f, alB = 1.f; bf16x8 pa0, pa1; const int NT = P.NT;
    int s_prev = 0, s_cur = 1, s_next = 2;
#define FR_HALF(t, X, ALX, Y, ALY) do { \
    FA_ALIGN(); FA_SBAR(); FR_QKT(X, s_cur, t); \
    finishSM1(Y, ALY, l_reg, pa0, pa1); FA_SBAR(); \
    if ((t) + 1 < NT) { FR_SWRITE(s_next); if ((t) + 2 < NT) FR_SLOAD(((t) + 2) * 64); } FA_SBAR(); \
    { const int vb_ = vb0 + s_prev * SHM_V; pv_na_pair<0>(o, vb_, pa0, pa1); pv_na_pair<2>(o, vb_, pa0, pa1); } \
    partialSM1(X, m_reg, ALX); FR_RESC(ALX); \
    __syncthreads(); { const int s_ = s_prev; s_prev = s_cur; s_cur = s_next; s_next = s_; } } while (0)
#define FR_VB() ((int)(uintptr_t)V_lds + v_rd_base(fresh_tid() & 63) - ((fresh_tid() >> 5) & 1) * 256 + (((((fresh_tid() >> 5) & 1) + m8) >> 1) * 4096) + (((((fresh_tid() >> 5) & 1) + m8) & 1) * 256))
#define FR_TAIL(Y, ALY) do { finishSM1(Y, ALY, l_reg, pa0, pa1); FA_SBAR(); const int vb1 = FR_VB() + s_prev * SHM_V; pv_na_pair<0>(o, vb1, pa0, pa1); pv_na_pair<2>(o, vb1, pa0, pa1); } while (0)
    FR_SLOAD(0); FR_SWRITE(0);
    if (NT > 1) { FR_SLOAD(64); FR_SWRITE(1); }
    __syncthreads();
    FR_QKT(pA, 0, 0); partialSM1(pA, m_reg, alA);
    if (NT > 2) FR_SLOAD(128);
    const int vb0 = FR_VB();
    int t = 1;
#pragma clang loop unroll(disable)
    for (; t + 1 < NT; t += 2) { FR_HALF(t, pB, alB, pA, alA); FR_HALF(t + 1, pA, alA, pB, alB); }
    if (t < NT) { FR_HALF(t, pB, alB, pA, alA); FR_TAIL(pB, alB); }
    else { FR_TAIL(pA, alA); }
    asm volatile("s_waitcnt vmcnt(0) lgkmcnt(0)" ::: "memory"); __syncthreads();
#undef FR_SLOAD
#undef FR_SWRITE
#undef FR_RESC
#undef FR_QKT
#undef FR_HALF
#undef FR_TAIL
#undef FR_VB
}
__device__ __forceinline__ void unit_na(const Ptrs& A, int b, int h, int qb, char* lds) {
    int tid = fresh_tid(), lane = tid & 63, wid = __builtin_amdgcn_readfirstlane(tid >> 6), r32 = lane & 31, hi = lane >> 5;
    const int R0 = qb * 4;
    long tok0 = (long)b * SEQ + (R0 + 2 * (wid >> 2)) * 64 + 16 * (wid & 3);
    { float* rp = (float*)(lds + L_RPB);
      for (int i = tid; i < 640; i += 512) { const int e = i - 64; float v = 0.f; if (e >= 0 && e < 480 && (e & 31) < 31) v = A.rpb[h * 465 + (e >> 5) * 31 + (e & 31)] * LOG2E; rp[i] = v; } }
    bf16x8 qr[8]; const bf16* qp = A.H1 + (tok0 + (r32 >> 4) * 64 + (r32 & 15)) * NIN + O_QC + h * 128 + hi * 8;
#pragma unroll
    for (int d0 = 0; d0 < 8; ++d0) qr[d0] = *(const bf16x8*)(qp + d0 * 16);
    const int rlo = min(max(R0 - 4, 0), 56), nt_na = min(max(R0 - 1, 0), 56) + 8 - rlo;
    CoreP P; P.K1 = mk_rsrc(A.ws, WS_BYTES); P.oK1 = OF_H1 + (unsigned)(((b * SEQ + rlo * 64) * NIN + O_KC + h * 128) * 2); P.K2 = P.K1; P.oK2 = 0; P.V = P.K1; P.oV = OF_H1 + (unsigned)(((b * SEQ + rlo * 64) * NIN + O_VC + h * 128) * 2);
    P.NT = nt_na; P.slope2 = 0.f; P.qrel0 = 0; P.R0 = R0; P.rlo = rlo;
    f32x16 o[4]; float l_reg; float rli[16];
    attn_core_na<NIN, NIN>(qr, P, o, l_reg, lds);
    tid = fresh_tid(); lane = tid & 63; wid = __builtin_amdgcn_readfirstlane(tid >> 6); r32 = lane & 31; hi = lane >> 5;
    tok0 = (long)b * SEQ + (R0 + 2 * (wid >> 2)) * 64 + 16 * (wid & 3);
    row_inv(l_reg, rli, lds, wid, r32, hi);
    store_gated<NIN, DM, true>(o, rli, mk_rsrc(A.ws, WS_BYTES), OF_H1 + (unsigned)((tok0 * NIN + O_GC + h * 128) * 2), OF_ATT + (unsigned)((tok0 * DM + h * 128) * 2), lds);
}
}


struct Frame {
    LAS unsigned char* lds;
    volatile LAS unsigned* MISC;
    gu32* ctl;
    int vcu, G;
};
struct Args { const float* in[19]; float* out; unsigned char* ws; int ph_lo, ph_hi; };

struct MapIn0 {
    __device__ __forceinline__ void operator()(int n, int& sc, float& cs) const {
        cs = 1.f;
        if (n < E_GB) { sc = n; if (n < 1024) cs = 0.125f * LOG2E; }
        else if (n < E_KR) sc = 5440 + (n - E_GB);
        else if (n < E_KR + 64) { const int j = n - E_KR; sc = 5376 + (j >> 1) + 32 * (j & 1); }
        else sc = -1;
    }
};
struct MapUq {
    __device__ __forceinline__ void operator()(int n, int& sc, float& cs) const {
        cs = 0.07216878364870322f * LOG2E;
        const int h = n / 192, r = n % 192;
        if (r < 128) sc = n; else { const int j = r - 128; sc = h * 192 + 128 + (j >> 1) + 32 * (j & 1); }
    }
};
struct MapId {
    int nsc; float cs0;
    __device__ __forceinline__ void operator()(int n, int& sc, float& cs) const { sc = n; cs = (n < nsc) ? cs0 : 1.f; }
};
template <class Map>
__device__ __forceinline__ void p0_transpose_item(const float* W, int K, int Nsrc, bf16* WT, int nblk, LAS float* scr, int item, int lane, const Map& mp, const float* kscale) {
    const int kb = item / nblk, nb = item % nblk, k0 = 64 * kb, n0 = 32 * nb;
    int sc; float cs; mp(n0 + (lane & 31), sc, cs);
    float wv[32];
    const float* wp = W + (size_t)(k0 + (lane >> 5)) * Nsrc + (sc >= 0 ? sc : 0);
#pragma unroll
    for (int i = 0; i < 32; ++i) wv[i] = wp[(size_t)(2 * i) * Nsrc];
#pragma unroll
    for (int i = 0; i < 32; ++i) { const int kk = 2 * i + (lane >> 5); float w = (sc >= 0) ? wv[i] * cs : 0.f; if (kscale) w *= kscale[k0 + kk]; scr[kk * 33 + (lane & 31)] = w; }
    LDS_WAIT(); asm volatile("" ::: "memory");
    const int c = lane & 7;
#pragma unroll
    for (int j = 0; j < 4; ++j) { const int n = (lane >> 3) + 8 * j; const LAS float* s = scr + (8 * c) * 33 + n;
        v4u o; o.x = pk2(s[0 * 33], s[1 * 33]); o.y = pk2(s[2 * 33], s[3 * 33]); o.z = pk2(s[4 * 33], s[5 * 33]); o.w = pk2(s[6 * 33], s[7 * 33]);
        *(GAS v4u*)(WT + (size_t)(n0 + n) * K + k0 + 8 * c) = o; }
    LDS_WAIT(); asm volatile("" ::: "memory");
}
template <class Map>
__device__ __forceinline__ void p0_transpose(Frame& F, int wave, int lane, const float* W, int K, int Nsrc, int Ndst, bf16* WT, const Map& mp, const float* kscale) {
    LAS float* scr = (LAS float*)(F.lds + RING_OFF + wave * 16384);
    const int gw = F.vcu * NWAVES + wave, NGW = F.G * NWAVES, nblk = Ndst / 32, nitems = (K / 64) * nblk;
    for (int it = gw; it < nitems; it += NGW) p0_transpose_item(W, K, Nsrc, WT, nblk, scr, it, lane, mp, kscale);
}
__device__ __forceinline__ void xn_row(const float* xrow, const float* gain, bf16* orow, int lane) {
    const GAS f32x4* xr = (const GAS f32x4*)xrow + lane; const GAS f32x4* gr = (const GAS f32x4*)gain + lane;
    f32x4 v[8]; float s = 0.f;
#pragma unroll
    for (int j = 0; j < 8; ++j) { v[j] = xr[64 * j]; s += (v[j].x * v[j].x + v[j].y * v[j].y) + (v[j].z * v[j].z + v[j].w * v[j].w); }
    const float rstd = 1.0f / sqrtf(wave_sum(s) * (1.f / DM) + EPS);
    GAS v2u* o8 = (GAS v2u*)orow + lane;
#pragma unroll
    for (int j = 0; j < 8; ++j) { const f32x4 g = gr[64 * j]; v2u o; o.x = pk2(v[j].x * rstd * g.x, v[j].y * rstd * g.y); o.y = pk2(v[j].z * rstd * g.z, v[j].w * rstd * g.w); o8[64 * j] = o; }
}
__device__ __forceinline__ void tab_entry(int pos, int i, float& c, float& s) {
    double inv = 1.0; for (int k = 0; k < i; ++k) inv *= 0.7498942093324559;
    const double ang = (double)pos * inv;
    const double kq = rint(ang * 0.6366197723675814);
    const double rr = (ang - kq * 1.5707963267948966) - kq * 6.123233995736766e-17;
    const int q = ((int)kq) & 3;
    const double r2 = rr * rr;
    const double sn = rr * (1.0 + r2 * (-1.0 / 6 + r2 * (1.0 / 120 + r2 * (-1.0 / 5040 + r2 * (1.0 / 362880 + r2 * (-1.0 / 39916800 + r2 * (1.0 / 6227020800.0)))))));
    const double cs = 1.0 + r2 * (-0.5 + r2 * (1.0 / 24 + r2 * (-1.0 / 720 + r2 * (1.0 / 40320 + r2 * (-1.0 / 3628800 + r2 * (1.0 / 479001600.0 + r2 * (-1.0 / 87178291200.0)))))));
    double cc, ss;
    if (q == 0) { cc = cs; ss = sn; } else if (q == 1) { cc = -sn; ss = cs; } else if (q == 2) { cc = -cs; ss = -sn; } else { cc = sn; ss = -cs; }
    c = (float)cc; s = (float)ss;
}

template <int NR> __device__ __forceinline__ void xn_rows(const float* x, const float* gain, bf16* XN, int m0, int mstep, int lane) {
    f32x4 v[NR][8]; float s[NR];
#pragma unroll
    for (int r = 0; r < NR; ++r) { const GAS f32x4* xr = (const GAS f32x4*)(x + (size_t)(m0 + r * mstep) * DM) + lane; s[r] = 0.f;
#pragma unroll
        for (int j = 0; j < 8; ++j) v[r][j] = __builtin_nontemporal_load(xr + 64 * j); }
    const GAS f32x4* gr = (const GAS f32x4*)gain + lane;
#pragma unroll
    for (int r = 0; r < NR; ++r) {
#pragma unroll
        for (int j = 0; j < 8; ++j) s[r] += (v[r][j].x * v[r][j].x + v[r][j].y * v[r][j].y) + (v[r][j].z * v[r][j].z + v[r][j].w * v[r][j].w);
        const float rstd = 1.0f / sqrtf(wave_sum(s[r]) * (1.f / DM) + EPS);
        GAS v2u* o8 = (GAS v2u*)(XN + (size_t)(m0 + r * mstep) * DM) + lane;
#pragma unroll
        for (int j = 0; j < 8; ++j) { const f32x4 g = gr[64 * j]; v2u o; o.x = pk2(v[r][j].x * rstd * g.x, v[r][j].y * rstd * g.y); o.y = pk2(v[r][j].z * rstd * g.z, v[r][j].w * rstd * g.w); o8[64 * j] = o; } }
}
template <int NR, bool WITH_XN, bool XIN_B = false, bool XOUT_B = false> __device__ __forceinline__ void resid_rows(const void* xin_, const bf16* MB, const float* RSS, const float* gpost, const float* gpre, void* xout_, bf16* XN, int m0, int mstep, int lane) {
    f32x4 v[NR][8]; v2u mw[NR][8]; float ssm[NR];
#pragma unroll
    for (int r = 0; r < NR; ++r) { const int m = m0 + r * mstep; const GAS v2u* mr = (const GAS v2u*)(MB + (size_t)m * DM) + lane;
        ssm[r] = lane < 32 ? RSS[(size_t)m * 32 + lane] : 0.f;
        if constexpr (XIN_B) { const GAS v2u* xr = (const GAS v2u*)((const bf16*)xin_ + (size_t)m * DM) + lane;
#pragma unroll
            for (int j = 0; j < 8; ++j) { const v2u w = __builtin_nontemporal_load(xr + 64 * j); v[r][j] = (f32x4){bflo(w.x), bfhi(w.x), bflo(w.y), bfhi(w.y)}; mw[r][j] = __builtin_nontemporal_load(mr + 64 * j); } }
        else { const GAS f32x4* xr = (const GAS f32x4*)((const float*)xin_ + (size_t)m * DM) + lane;
#pragma unroll
            for (int j = 0; j < 8; ++j) { v[r][j] = __builtin_nontemporal_load(xr + 64 * j); mw[r][j] = __builtin_nontemporal_load(mr + 64 * j); } } }
    const GAS f32x4* g2 = (const GAS f32x4*)gpost + lane; const GAS f32x4* g1 = (const GAS f32x4*)gpre + lane;
#pragma unroll
    for (int r = 0; r < NR; ++r) { const int m = m0 + r * mstep; const float rm = 1.0f / sqrtf(wave_sum(ssm[r]) * (1.f / DM) + EPS);
        GAS f32x4* orow = (GAS f32x4*)((float*)xout_ + (size_t)m * DM) + lane; GAS v2u* orowb = (GAS v2u*)((bf16*)xout_ + (size_t)m * DM) + lane; float s = 0.f;
#pragma unroll
        for (int j = 0; j < 8; ++j) { const f32x4 xv = v[r][j], g = g2[64 * j]; const v2u w = mw[r][j];
            f32x4 t; t.x = xv.x + bflo(w.x) * rm * g.x; t.y = xv.y + bfhi(w.x) * rm * g.y; t.z = xv.z + bflo(w.y) * rm * g.z; t.w = xv.w + bfhi(w.y) * rm * g.w;
            v[r][j] = t; if constexpr (XOUT_B) { v2u ob; ob.x = pk2(t.x, t.y); ob.y = pk2(t.z, t.w); __builtin_nontemporal_store(ob, orowb + 64 * j); } else __builtin_nontemporal_store(t, orow + 64 * j);
            s += (t.x * t.x + t.y * t.y) + (t.z * t.z + t.w * t.w); }
        if constexpr (WITH_XN) { const float rstd = 1.0f / sqrtf(wave_sum(s) * (1.f / DM) + EPS); GAS v2u* o8 = (GAS v2u*)(XN + (size_t)m * DM) + lane;
#pragma unroll
            for (int j = 0; j < 8; ++j) { const f32x4 g = g1[64 * j]; v2u o; o.x = pk2(v[r][j].x * rstd * g.x, v[r][j].y * rstd * g.y); o.y = pk2(v[r][j].z * rstd * g.z, v[r][j].w * rstd * g.w); o8[64 * j] = o; } } }
}

__global__ void __launch_bounds__(NWAVES * 64, 2) mega(Args args) {
    extern __shared__ __attribute__((aligned(16))) unsigned char lds[];
    Frame F;
    F.lds = (LAS unsigned char*)lds;
    F.MISC = (volatile LAS unsigned*)(F.lds + MISC_OFF);
    F.G = gridDim.x; { const int bx = blockIdx.x; F.vcu = (F.G % 8 == 0) ? (bx % 8) * (F.G / 8) + bx / 8 : bx; }
    unsigned char* ws = args.ws;
    F.ctl = (gu32*)(ws + WS_CTL);
    for (int u = threadIdx.x; u < (LDS_BYTES - LDSCTL_OFF) / 4; u += NWAVES * 64) ((LAS unsigned*)(F.lds + LDSCTL_OFF))[u] = 0u;
    __syncthreads();
    const int lo = args.ph_lo, hi = args.ph_hi;
    const bool use_bar = (hi - lo) > 1;
    XcdBarrier bar; bar.bar = (unsigned*)(F.ctl + CW_BAR); bar.x = 0; bar.st = nullptr;
    if (use_bar) bar = xcd_barrier_post((unsigned*)(F.ctl + CW_BAR), F.MISC + 8);
#define IN(k) (lo <= (k) && (k) < hi)
#define SEAM(k) do { if (IN(k) && IN((k) + 1)) xcd_barrier(bar); } while (0)
    const float* x = args.in[0];
    bf16* WIN0 = (bf16*)(ws + WS_WIN0); bf16* WOUT0 = (bf16*)(ws + WS_WOUT0); bf16* WUQ = (bf16*)(ws + WS_WUQ); bf16* WUKV = (bf16*)(ws + WS_WUKV);
    bf16* WIN1 = (bf16*)(ws + WS_WIN1); bf16* WOUT1 = (bf16*)(ws + WS_WOUT1);
    bf16* XN = (bf16*)(ws + WS_XN); bf16* KVM = (bf16*)(ws + WS_KVM); bf16* H1 = (bf16*)(ws + WS_H1); bf16* MB = (bf16*)(ws + WS_MB); bf16* QM = (bf16*)(ws + WS_QM);
    bf16* X1B = (bf16*)(ws + WS_X1B); bf16* ATT = (bf16*)(ws + WS_ATT); bf16* KPE = (bf16*)(ws + WS_KPE); bf16* KG = (bf16*)(ws + WS_KG);
    unsigned* KMAX = (unsigned*)(ws + WS_CTL) + CW_KMAX; float* RSS = (float*)(ws + WS_RSS); float* SSQ = (float*)(ws + WS_SSQ); float* CONSTS = (float*)(ws + WS_CONST); f32x2* TAB = (f32x2*)(ws + WS_TAB);
    const int NGW = F.G * NWAVES, NGT = NGW * 64;
#define PHASE_IDS() const int tid = fresh_tid(), lane = tid & 63, wave = __builtin_amdgcn_readfirstlane(tid >> 6), gw = F.vcu * NWAVES + wave, gt = gw * 64 + lane; (void)gt; (void)gw; (void)lane; (void)wave

    if (IN(0)) {
        PHASE_IDS();
        { LAS float* scr = (LAS float*)(F.lds + RING_OFF + wave * 16384);
          constexpr int I_IN = (DM / 64) * (NIN / 32), I_OUT = (DM / 64) * (DM / 32), I_UQ = (768 / 64) * (1536 / 32), I_UKV = (512 / 64) * (2048 / 32), I_ALL = I_IN + I_OUT + I_UQ + I_UKV;
          for (int it = gw; it < I_ALL; it += NGW) { int r = it;
              if (r < I_IN) { p0_transpose_item(args.in[3], DM, 6464, WIN0, NIN / 32, scr, r, lane, MapIn0{}, nullptr); continue; } r -= I_IN;
              if (r < I_OUT) { p0_transpose_item(args.in[4], DM, DM, WOUT0, DM / 32, scr, r, lane, MapId{0, 1.f}, nullptr); continue; } r -= I_OUT;
              if (r < I_UQ) { p0_transpose_item(args.in[11], 768, 1536, WUQ, 1536 / 32, scr, r, lane, MapUq{}, args.in[10]); continue; } r -= I_UQ;
              p0_transpose_item(args.in[13], 512, 2048, WUKV, 2048 / 32, scr, r, lane, MapId{0, 1.f}, args.in[12]); } }
        { int mm = gw; for (; mm + NGW < MTOK; mm += 2 * NGW) xn_rows<2>(x, args.in[1], XN, mm, NGW, lane); if (mm < MTOK) xn_rows<1>(x, args.in[1], XN, mm, NGW, lane); }
        for (int e = gt; e < 4096 * 32; e += NGT) { float c, s; tab_entry(e >> 5, e & 31, c, s); TAB[e] = (f32x2){c, s}; }
        if (gw == 0) { const float a1 = wave_sum(args.in[5][lane] * args.in[6][lane]), a2 = wave_sum(args.in[7][lane] * args.in[8][lane]); if (lane == 0) CONSTS[0] = expf(a1) - expf(a2) + 0.2f; }
    }
    SEAM(0);
    if (IN(1)) {
        pg8::Gemm g{XN, WIN0, MTOK, NIN, DM, DM}; pg8::StaticOrder S; S.init(MTOK, NIN, F.G, (int)blockIdx.x);
        pg8::EpiOut E{H1, NIN, nullptr, 0, 0, 0.f, 0.f, SSQ, SSLD, E_CQ / 256, E_GB / 256, nullptr};
        pg8::gemm_phase<pg8::EpiOut, pg8::StaticOrder, GEMM_ALIGN, GEMM_SP2>(F.lds + RING_OFF, g, S, E);
        { const int nun = (MTOK / 256) * (NIN / 256), rem = nun % F.G, nlight = (rem == 0) ? F.G : F.G - rem, lid = (rem == 0) ? (int)blockIdx.x : (int)blockIdx.x - rem;
          if (lid >= 0) { PHASE_IDS(); LAS float* scr = (LAS float*)(F.lds + RING_OFF + wave * 16384);
              constexpr int I_IN = (DM / 64) * (NIN / 32), I_OUT = (DM / 64) * (DM / 32);
              for (int it = lid * NWAVES + wave; it < I_IN + I_OUT; it += nlight * NWAVES) {
                  if (it < I_IN) p0_transpose_item(args.in[14], DM, 6656, WIN1, NIN / 32, scr, it, lane, MapId{1024, 0.08838834764831845f * LOG2E}, nullptr);
                  else p0_transpose_item(args.in[15], DM, DM, WOUT1, DM / 32, scr, it - I_IN, lane, MapId{0, 1.f}, nullptr); } } }
    }
    SEAM(1);
    if (IN(2)) {
        PHASE_IDS();
        for (int e = gt; e < MTOK * 32; e += NGT) { const int tok = e >> 5, i = e & 31; const unsigned w = *(const unsigned*)(H1 + (size_t)tok * NIN + E_KR + 2 * i);
            const f32x2 cs = TAB[(tok % SEQ) * 32 + i]; const float x1 = bflo(w), x2 = bfhi(w); *(unsigned*)(KPE + (size_t)tok * 64 + 2 * i) = pk2(x1 * cs.x - x2 * cs.y, x1 * cs.y + x2 * cs.x); }
        { float mx = 0.f; int curb = -1;
          for (int m0 = gw; m0 < MTOK; m0 += 4 * NGW) { v4u w0[4], w1[4];
#pragma unroll
              for (int u = 0; u < 4; ++u) { const int mt = m0 + u * NGW; if (mt < MTOK) { const bf16* kp = H1 + (size_t)mt * NIN + E_KA + 16 * lane; w0[u] = *(const v4u*)kp; w1[u] = *(const v4u*)(kp + 8); } else { w0[u] = (v4u){0u, 0u, 0u, 0u}; w1[u] = w0[u]; } }
#pragma unroll
              for (int u = 0; u < 4; ++u) { const int mt = m0 + u * NGW; if (mt < MTOK) { const int b = mt / SEQ;
                  if (b != curb) { if (curb >= 0 && (lane & 3) == 0) atomicMax(KMAX + fa::KM_DIFF + curb * 16 + (lane >> 2), __float_as_uint(mx)); mx = 0.f; curb = b; }
                  float ss = 0.f;
#pragma unroll
                  for (int e = 0; e < 4; ++e) { ss += bflo(w0[u][e]) * bflo(w0[u][e]) + bfhi(w0[u][e]) * bfhi(w0[u][e]); ss += bflo(w1[u][e]) * bflo(w1[u][e]) + bfhi(w1[u][e]) * bfhi(w1[u][e]); }
                  ss += __shfl_xor(ss, 1); ss += __shfl_xor(ss, 2); mx = fmaxf(mx, ss); } } }
          if (curb >= 0 && (lane & 3) == 0) atomicMax(KMAX + fa::KM_DIFF + curb * 16 + (lane >> 2), __float_as_uint(mx)); }
        { pg8::Gemm g{H1 + E_CQ, WUQ, MTOK, QMW, 768, NIN}; pg8::StaticOrder S; S.init(MTOK, QMW, F.G, (int)blockIdx.x);
          pg8::EpiOut E{QM, QMW, SSQ, SSLD, 12, 1.f / 768, EPS, nullptr, 0, 0, 0, nullptr};
          pg8::gemm_phase<pg8::EpiOut, pg8::StaticOrder, GEMM_ALIGN, GEMM_SP2>(F.lds + RING_OFF, g, S, E); }
        { pg8::Gemm g{H1 + E_CKV, WUKV, MTOK, KVW, 512, NIN}; pg8::SplitOrder S; S.init(MTOK, KVW, F.G, (int)blockIdx.x); S.nlo = F.G / 2; S.lo = 1; S.hi = 3;
          pg8::EpiOut E{KVM, KVW, SSQ + 12, SSLD, 8, 1.f / 512, EPS, nullptr, 0, 0, 0, nullptr};
          if (F.G == 256) pg8::gemm_phase<pg8::EpiOut, pg8::SplitOrder, GEMM_ALIGN, GEMM_SP2>(F.lds + RING_OFF, g, S, E);
          else { pg8::StaticOrder S0; S0.init(MTOK, KVW, F.G, (int)(F.G - 1 - blockIdx.x)); pg8::gemm_phase<pg8::EpiOut, pg8::StaticOrder, GEMM_ALIGN, GEMM_SP2>(F.lds + RING_OFF, g, S0, E); } }
    }
    SEAM(2);
    if (IN(3)) {
        PHASE_IDS();
        const fa::Ptrs A{H1, QM, KVM, KPE, KG, ATT, TAB, CONSTS, args.in[9], args.in[17], args.in[16], args.out, KMAX, ws};
        unsigned* QC = (unsigned*)(ws + WS_CTL) + CW_QCTR; volatile LAS unsigned* qslot = F.MISC + 16;
        const int q0 = (F.vcu * 8) / F.G;
        for (int qq = 0; qq < 8; ++qq) { const int queue = (q0 + qq) & 7;
            for (;;) {
                int z = 0; asm volatile("" : "+v"(z));
                if (tid == 0) qslot[z] = atomicAdd(QC + 64 * queue, 1u);
                __syncthreads();
                const int idx = __builtin_amdgcn_readfirstlane((int)qslot[z]);
                __syncthreads();
                if (idx >= 128) break;
                int type, h, qbl;
                if (idx < 32) { type = 0; h = 7 - (idx >> 3); qbl = idx & 7; } else if (idx < 96) { type = 1; h = (idx - 32) >> 3; qbl = (idx - 32) & 7; } else { type = 0; h = 3 - ((idx - 96) >> 3); qbl = (idx - 96) & 7; }
                const int b = queue >> 1, qb = (queue & 1) * 8 + qbl;
                if (type == 0) fa::unit_diff(A, b, h, qb, (char*)lds + RING_OFF);
                else fa::unit_mla(A, b, h, qb, (char*)lds + RING_OFF);
            } }
    }
    SEAM(3);
    if (IN(4)) {
        pg8::Gemm g{ATT, WOUT0, MTOK, DM, DM, DM}; pg8::StaticOrder S; S.init(MTOK, DM, F.G, (int)blockIdx.x);
        pg8::EpiOut E{MB, DM, nullptr, 0, 0, 0.f, 0.f, RSS, 32, 0, 8, nullptr};
        pg8::gemm_phase<pg8::EpiOut, pg8::StaticOrder, GEMM_ALIGN, GEMM_SP2>(F.lds + RING_OFF, g, S, E);
    }
    SEAM(4);
    if (IN(5)) {
        PHASE_IDS();
        { int mm = gw; for (; mm + NGW < MTOK; mm += 2 * NGW) resid_rows<2, true, false, true>(x, MB, RSS, args.in[2], args.in[1] + DM, X1B, XN, mm, NGW, lane);
          if (mm < MTOK) resid_rows<1, true, false, true>(x, MB, RSS, args.in[2], args.in[1] + DM, X1B, XN, mm, NGW, lane); }
    }
    SEAM(5);
    if (IN(6)) {
        pg8::Gemm g{XN, WIN1, MTOK, NIN, DM, DM}; pg8::StaticOrder S; S.init(MTOK, NIN, F.G, (int)blockIdx.x);
        pg8::EpiOut E{H1, NIN, nullptr, 0, 0, 0.f, 0.f, nullptr, 0, 0, 0, nullptr};
        pg8::gemm_phase<pg8::EpiOut, pg8::StaticOrder, GEMM_ALIGN, GEMM_SP2>(F.lds + RING_OFF, g, S, E);
    }
    SEAM(6);
    if (IN(7)) {
        PHASE_IDS();
        const int hh = lane >> 5, i = lane & 31; const float* kn = args.in[18];
        const float g0 = kn[i], g1 = kn[i + 32], g2 = kn[i + 64], g3 = kn[i + 96];
        for (int m0 = gw; m0 < MTOK; m0 += 4 * NGW) {
            float a[4][4]; f32x2 c1[4], c2[4];
#pragma unroll
            for (int u = 0; u < 4; ++u) { const int m = min(m0 + u * NGW, MTOK - 1); const bf16* kp = H1 + (size_t)m * NIN + O_KD + hh * 128;
                a[u][0] = bf1(kp[i]); a[u][1] = bf1(kp[i + 32]); a[u][2] = bf1(kp[i + 64]); a[u][3] = bf1(kp[i + 96]);
                const int t = m % SEQ; c1[u] = TAB[(t >> 6) * 32 + i]; c2[u] = TAB[(t & 63) * 32 + i]; }
#pragma unroll
            for (int u = 0; u < 4; ++u) { const int m = m0 + u * NGW; if (m < MTOK) {
                float ss = (a[u][0] * a[u][0] + a[u][1] * a[u][1]) + (a[u][2] * a[u][2] + a[u][3] * a[u][3]);
#pragma unroll
                for (int o = 1; o < 32; o <<= 1) ss += __shfl_xor(ss, o);
                const float rstd = 1.0f / sqrtf(ss * (1.f / 128) + EPS);
                const float x1 = a[u][0] * rstd * g0, x2 = a[u][1] * rstd * g1, y1 = a[u][2] * rstd * g2, y2 = a[u][3] * rstd * g3;
                bf16* op = KG + (size_t)m * 256 + hh * 128;
                op[i] = (bf16)f2bf(x1 * c1[u].x - x2 * c1[u].y); op[i + 32] = (bf16)f2bf(x1 * c1[u].y + x2 * c1[u].x); op[i + 64] = (bf16)f2bf(y1 * c2[u].x - y2 * c2[u].y); op[i + 96] = (bf16)f2bf(y1 * c2[u].y + y2 * c2[u].x); } }
        }
    }
    SEAM(7);
    if (IN(8)) {
        PHASE_IDS();
        const fa::Ptrs A{H1, QM, KVM, KPE, KG, ATT, TAB, CONSTS, args.in[9], args.in[17], args.in[16], args.out, KMAX, ws};
        for (int i = 0;; ++i) { const int u = i * F.G + F.vcu; if (u >= 1024) break; const int type = u >> 9, idx = u & 511, bh = idx >> 4, qb = idx & 15;
            if (type == 0) fa::unit_na(A, bh >> 3, bh & 7, qb, (char*)lds + RING_OFF);
            else fa::unit_gqa(A, bh >> 3, bh & 7, qb, (char*)lds + RING_OFF); }
    }
    SEAM(8);
    if (IN(9)) {
        pg8::Gemm g{ATT, WOUT1, MTOK, DM, DM, DM}; pg8::StaticOrder S; S.init(MTOK, DM, F.G, (int)blockIdx.x);
        pg8::EpiOut E{MB, DM, nullptr, 0, 0, 0.f, 0.f, RSS, 32, 0, 8, nullptr};
        pg8::gemm_phase<pg8::EpiOut, pg8::StaticOrder, GEMM_ALIGN, GEMM_SP2>(F.lds + RING_OFF, g, S, E);
    }
    SEAM(9);
    if (IN(10)) {
        PHASE_IDS();
        { int mm = gw; for (; mm + NGW < MTOK; mm += 2 * NGW) resid_rows<2, false, true, false>(X1B, MB, RSS, args.in[2] + DM, nullptr, args.out, nullptr, mm, NGW, lane);
          if (mm < MTOK) resid_rows<1, false, true, false>(X1B, MB, RSS, args.in[2] + DM, nullptr, args.out, nullptr, mm, NGW, lane); }
    }
#undef IN
#undef SEAM
#undef PHASE_IDS
}

extern "C" void kernel_launch(void* const* d_in, const int* in_sizes, int n_in, void* d_out, int out_size, void* d_ws, size_t ws_size, hipStream_t stream) {
    static int grid = 0;
    if (grid == 0) {
        if (n_in != 19 || in_sizes[0] != MTOK * DM || out_size != MTOK * DM || ws_size < WS_END) {
            fprintf(stderr, "kernel_launch: unexpected shapes: n_in %d in0 %d out %d ws %zu (need >= %zu)\n", n_in, n_in > 0 ? in_sizes[0] : -1, out_size, ws_size, (size_t)WS_END); grid = -1; return; }
        int dev = 0, cus = 0, per_cu = 0;
        if (hipGetDevice(&dev) != hipSuccess || hipDeviceGetAttribute(&cus, hipDeviceAttributeMultiprocessorCount, dev) != hipSuccess) { grid = -1; return; }
        if (hipFuncSetAttribute((const void*)mega, hipFuncAttributeMaxDynamicSharedMemorySize, LDS_BYTES) != hipSuccess) { fprintf(stderr, "kernel_launch: hipFuncSetAttribute failed\n"); grid = -1; return; }
        if (hipOccupancyMaxActiveBlocksPerMultiprocessor(&per_cu, (const void*)mega, NWAVES * 64, LDS_BYTES) != hipSuccess || per_cu < 1) { fprintf(stderr, "kernel_launch: occupancy query failed (%d)\n", per_cu); per_cu = 1; }
        (void)hipGetLastError();
        grid = cus * per_cu;
    }
    if (grid < 0) return;
    (void)hipMemsetAsync((char*)d_ws + WS_CTL, 0, CTL_ZERO_BYTES, stream);
    Args a{};
    for (int i = 0; i < 19; ++i) a.in[i] = (const float*)d_in[i];
    a.out = (float*)d_out; a.ws = (unsigned char*)d_ws;
#if SINGLE_LAUNCH
    a.ph_lo = 0; a.ph_hi = 11;
    void* kargs[] = {(void*)&a};
    const hipError_t ce = hipLaunchCooperativeKernel((const void*)mega, dim3(grid), dim3(NWAVES * 64), kargs, LDS_BYTES, stream);
    if (ce != hipSuccess) fprintf(stderr, "kernel_launch: cooperative launch failed: %s (grid %d)\n", hipGetErrorName(ce), grid);
#else
    for (int k = 0; k < 11; ++k) { a.ph_lo = k; a.ph_hi = k + 1; hipLaunchKernelGGL(mega, dim3(grid), dim3(NWAVES * 64), LDS_BYTES, stream, a); }
#endif
    const hipError_t le = hipPeekAtLastError();
    if (le != hipSuccess) fprintf(stderr, "kernel_launch: launch failed: %s\n", hipGetErrorName(le));
}
```

```cpp
#define PAD_P0 0
#define PAD_P3 8
#define PAD_P4 0
#define PAD_P7 8
#include <hip/hip_runtime.h>
#include <hip/hip_bf16.h>
#include <cstdio>
#include <cstdint>
#include <cmath>
__device__ __forceinline__ int fresh_tid() { int t = threadIdx.x; asm volatile("" : "+v"(t)); return t; }
namespace pg8 {
#define PG8_LAS __attribute__((address_space(3)))
typedef unsigned short bf16_t;
typedef short bf16x8 __attribute__((ext_vector_type(8)));
typedef float f32x4 __attribute__((ext_vector_type(4)));
typedef unsigned u32x4 __attribute__((ext_vector_type(4)));
constexpr int BM = 256, BK = 64, HALF = 128, HTB = HALF * BK * 2  , STAGE_BYTES = 8 * HTB, NXCD = 8, WGM = 8;

__host__ __device__ __forceinline__ int lds_byte(int r, int c) { const int st = (r >> 4) * 2 + (c >> 5), rr = r & 15, cc = c & 31, ob = rr * 64 + cc * 2; return st * 1024 + (ob ^ (((ob >> 9) & 1) << 5)); }
__host__ __device__ __forceinline__ void stage_rc(int b, int& R, int& C) { const int st = b / 1024, sb = b % 1024, swz = sb ^ (((sb >> 9) & 1) << 5); R = (st >> 1) * 16 + swz / 64; C = (st & 1) * 32 + (swz % 64) / 2; }
__host__ __device__ __forceinline__ int perm32(int rho) { const int n = rho >> 4, i = rho & 15; return 8 * (i >> 2) + 4 * n + (i & 3); }

struct Unit { int pm, pn; };
struct Gemm { const bf16_t* A; const bf16_t* Bt; int M, N, K, lda; };

struct StaticOrder {
    int nM, nN, nwg, G, c;
    __host__ __device__ void init(int M, int N, int G_, int c_) { nM = M / BM; nN = N / BM; nwg = nM * nN; G = G_; c = c_; }
    __host__ __device__ bool next(int i, Unit& u) const {
        const long L = (long)i * G + c; if (L >= nwg) return false;
        int wgid = (int)L; { const int q = nwg / NXCD, r = nwg % NXCD, xcd = wgid % NXCD, off = wgid / NXCD; wgid = (xcd < r ? xcd * (q + 1) : r * (q + 1) + (xcd - r) * q) + off; }
        const int nig = WGM * nN, gid = wgid / nig, fm = gid * WGM, gsz = (nM - fm) < WGM ? (nM - fm) : WGM;
        u.pm = fm + ((wgid % nig) % gsz); u.pn = (wgid % nig) / gsz; return true;
    }
    __device__ __forceinline__ void a_ready(const Unit&) const {}
    __device__ __forceinline__ void done(const Unit&) const {}
};
struct SplitOrder : StaticOrder {
    int nlo, lo, hi;
    __host__ __device__ bool next(int i, Unit& u) const {
        long L;
        if (c < nlo) { if (i >= lo) return false; L = (long)hi * (G - nlo) + (long)i * nlo + c; }
        else { if (i >= hi) return false; L = (long)i * (G - nlo) + (c - nlo); }
        if (L >= nwg) return false;
        int wgid = (int)L; { const int q = nwg / NXCD, r = nwg % NXCD, xcd = wgid % NXCD, off = wgid / NXCD; wgid = (xcd < r ? xcd * (q + 1) : r * (q + 1) + (xcd - r) * q) + off; }
        const int nig = WGM * nN, gid = wgid / nig, fm = gid * WGM, gsz = (nM - fm) < WGM ? (nM - fm) : WGM;
        u.pm = fm + ((wgid % nig) % gsz); u.pn = (wgid % nig) / gsz; return true;
    }
};
__device__ __forceinline__ unsigned cvt_pk_bf16(float lo, float hi) { unsigned r; asm volatile("v_cvt_pk_bf16_f32 %0, %1, %2" : "=v"(r) : "v"(lo), "v"(hi)); return r; }
typedef unsigned u32x4e __attribute__((ext_vector_type(4)));
struct EpiOut {
    static constexpr bool PERM = true, AFTER_DRAIN = false;
    bf16_t* O; int ldc;
    const float* rs_in; int rs_ld, rs_n; float rs_invk, rs_eps;
    float* ss_out; int ss_ld, ss_pn0, ss_pn1;
    unsigned* kmax;
    __device__ __forceinline__ void operator()(const f32x4 (&acc)[2][2][4][2], const Unit& u, int wr, int wc, int fr, int fq) const {
        const int row0 = u.pm * BM + wr * 64 + fr;
        const int col0 = u.pn * BM + wc * 32 + 8 * fq;
        const bool do_ss = (ss_out != nullptr) && (u.pn >= ss_pn0) && (u.pn < ss_pn1);
        float kmx = 0.f;
#pragma unroll
        for (int ai = 0; ai < 2; ++ai) {
            float rsc[4];
            if (rs_in) { f32x4 part[4][3];
#pragma unroll
                for (int q = 0; q < 4; ++q) { const float* p = rs_in + (size_t)(row0 + ai * HALF + q * 16) * rs_ld;
#pragma unroll
                    for (int i = 0; i < 3; ++i) part[q][i] = (4 * i < rs_n) ? *(const f32x4*)(p + 4 * i) : (f32x4){0.f, 0.f, 0.f, 0.f}; }
#pragma unroll
                for (int q = 0; q < 4; ++q) { float s = 0.f;
#pragma unroll
                    for (int i = 0; i < 3; ++i) s += (part[q][i][0] + part[q][i][1]) + (part[q][i][2] + part[q][i][3]);
                    rsc[q] = 1.0f / sqrtf(s * rs_invk + rs_eps); } }
            else {
#pragma unroll
                for (int q = 0; q < 4; ++q) rsc[q] = 1.f; }
#pragma unroll
            for (int m = 0; m < 4; ++m) {
                const int row = row0 + ai * HALF + m * 16;
                const float sc = rsc[m];
                bf16_t* rowp = O + (size_t)row * ldc + col0;
                float ssq = 0.f;
#pragma unroll
                for (int bj = 0; bj < 2; ++bj) {
                    const f32x4 v0 = acc[ai][bj][m][0] * sc, v1 = acc[ai][bj][m][1] * sc;
                    u32x4e w; w.x = cvt_pk_bf16(v0[0], v0[1]); w.y = cvt_pk_bf16(v0[2], v0[3]); w.z = cvt_pk_bf16(v1[0], v1[1]); w.w = cvt_pk_bf16(v1[2], v1[3]);
                    *(u32x4e*)(rowp + bj * HALF) = w;
                    if (do_ss) {
#pragma unroll
                        for (int e = 0; e < 4; ++e) { const float lo = __uint_as_float(w[e] << 16), hi = __uint_as_float(w[e] & 0xffff0000u); ssq += lo * lo + hi * hi; }
                    }
                    if (kmax && bj == 0) { float kn = 0.f;
#pragma unroll
                        for (int e = 0; e < 4; ++e) { const float lo = __uint_as_float(w[e] << 16), hi = __uint_as_float(w[e] & 0xffff0000u); kn += lo * lo + hi * hi; }
                        kn += __shfl_xor(kn, 16); kn += __shfl_xor(kn, 32); kmx = fmaxf(kmx, kn); }
                }
                if (do_ss) { ssq += __shfl_xor(ssq, 16); ssq += __shfl_xor(ssq, 32); if (fq == 0) ss_out[(size_t)row * ss_ld + (u.pn - ss_pn0) * 4 + wc] = ssq; }
            }
        }
        if (kmax) {
#pragma unroll
            for (int x = 1; x < 16; x <<= 1) kmx = fmaxf(kmx, __shfl_xor(kmx, x));
            if (fr == 0 && fq == 0) atomicMax(kmax + ((u.pm >> 4) * 8 + u.pn) * 4 + wc, __float_as_uint(kmx));
        }
    }
};
template <class Epi, class Sched, bool ALIGN_EPI = false, bool SP2 = false>
__device__ __forceinline__ void gemm_phase(PG8_LAS unsigned char* lds, const Gemm g, const Sched& S, const Epi& E) {
    const int tid = fresh_tid(), wid = __builtin_amdgcn_readfirstlane(tid >> 6), lane = tid & 63, wr = wid >> 2, wc = wid & 3, fr = lane & 15, fq = lane >> 4;
    const int K = g.K, nt = K / BK;
    unsigned voffA[2], voffB[2];
#pragma unroll
    for (int i = 0; i < 2; ++i) { int R, C; stage_rc(tid * 16 + i * 8192, R, C); const int Rb = Epi::PERM ? ((R & ~31) + perm32(R & 31)) : R;
        voffA[i] = (unsigned)(R * g.lda + C) * 2u; voffB[i] = (unsigned)(Rb * K + C) * 2u; }
    const size_t kstep = (size_t)(BK * 2);
    const size_t hstepA = (size_t)HALF * g.lda * 2, hstepB = (size_t)HALF * K * 2;
    const size_t tstepA = 2 * hstepA, tstepB = 2 * hstepB;
    const unsigned ldsw = (unsigned)wid * 1024u;
    const int aoff = lds_byte(wr * 64 + fr, fq * 8), boff = lds_byte(wc * 32 + fr, fq * 8);
#define PG8_SA(b, h) (((b) * 2 + (h)) * HTB)
#define PG8_SB(b, h) ((4 + (b) * 2 + (h)) * HTB)
#define PG8_STAGE(bufoff, gbase, voff) do { _Pragma("unroll") for (int _i = 0; _i < 2; ++_i) \
        __builtin_amdgcn_global_load_lds((const unsigned*)((const char*)(gbase) + (voff)[_i]), (PG8_LAS unsigned*)(lds + (bufoff) + ldsw + _i * 8192), 16, 0, 0); } while (0)
#define PG8_LDA(dst, b, h) do { _Pragma("unroll") for (int m = 0; m < 4; ++m) _Pragma("unroll") for (int k = 0; k < 2; ++k) dst[m][k] = *(const PG8_LAS bf16x8*)(lds + PG8_SA(b, h) + aoff + m * 2048 + k * 1024); } while (0)
#define PG8_LDB(dst, b, h) do { _Pragma("unroll") for (int n = 0; n < 2; ++n) _Pragma("unroll") for (int k = 0; k < 2; ++k) dst[n][k] = *(const PG8_LAS bf16x8*)(lds + PG8_SB(b, h) + boff + n * 2048 + k * 1024); } while (0)
#define PG8_MMA(ai, bj, At, Bt) do { __builtin_amdgcn_s_setprio(1); _Pragma("unroll") for (int m = 0; m < 4; ++m) _Pragma("unroll") for (int n = 0; n < 2; ++n) _Pragma("unroll") for (int k = 0; k < 2; ++k) \
        acc[ai][bj][m][n] = __builtin_amdgcn_mfma_f32_16x16x32_bf16(Bt[n][k], At[m][k], acc[ai][bj][m][n], 0, 0, 0); __builtin_amdgcn_s_setprio(0); } while (0)
#define PG8_WAIT_V(n) asm volatile("s_waitcnt vmcnt(" #n ")" ::: "memory")
#define PG8_WAIT_L(n) asm volatile("s_waitcnt lgkmcnt(" #n ")" ::: "memory")
#define PG8_BAR __builtin_amdgcn_s_barrier()
#define PG8_SCHED __builtin_amdgcn_sched_barrier(0)
    Unit cur, nxt; int ui = 0;
    if (!S.next(0, cur)) return;
    f32x4 acc[2][2][4][2];
#pragma unroll
    for (int a = 0; a < 2; ++a)
#pragma unroll
        for (int b = 0; b < 2; ++b)
#pragma unroll
            for (int m = 0; m < 4; ++m)
#pragma unroll
                for (int n = 0; n < 2; ++n) acc[a][b][m][n] = (f32x4){0.f, 0.f, 0.f, 0.f};
    bf16x8 At[4][2], B0[2][2], B1[2][2];
    const char* cA = (const char*)g.A + (size_t)cur.pm * tstepA; const char* cB = (const char*)g.Bt + (size_t)cur.pn * tstepB;
    S.a_ready(cur);
    if constexpr (SP2) {
        PG8_STAGE(PG8_SB(0, 0), cB, voffB); PG8_STAGE(PG8_SB(0, 1), cB + hstepB, voffB); PG8_STAGE(PG8_SA(0, 0), cA, voffA); PG8_STAGE(PG8_SA(0, 1), cA + hstepA, voffA);
        if (wr == 1) PG8_BAR;
        PG8_WAIT_V(2); PG8_BAR;
        PG8_STAGE(PG8_SB(1, 0), cB + kstep, voffB); PG8_STAGE(PG8_SA(1, 0), cA + kstep, voffA); PG8_STAGE(PG8_SB(1, 1), cB + hstepB + kstep, voffB);
        PG8_WAIT_V(6); PG8_BAR;
    } else {
        PG8_STAGE(PG8_SB(0, 0), cB, voffB); PG8_STAGE(PG8_SA(0, 0), cA, voffA); PG8_STAGE(PG8_SB(0, 1), cB + hstepB, voffB); PG8_STAGE(PG8_SA(0, 1), cA + hstepA, voffA);
        if (wr == 1) PG8_BAR;
        PG8_WAIT_V(4); PG8_BAR;
        PG8_STAGE(PG8_SB(1, 0), cB + kstep, voffB); PG8_STAGE(PG8_SA(1, 0), cA + kstep, voffA); PG8_STAGE(PG8_SB(1, 1), cB + hstepB + kstep, voffB);
        PG8_WAIT_V(6); PG8_BAR;
    }
    for (;;) {
        const bool has_next = S.next(ui + 1, nxt);
        const char* nA = has_next ? (const char*)g.A + (size_t)nxt.pm * tstepA : cA; const char* nB = has_next ? (const char*)g.Bt + (size_t)nxt.pn * tstepB : cB;
        for (int t = 0; t < nt; t += 2) {
            const bool last = (t == nt - 2);
            const char* a1 = cA + (size_t)(t + 1) * kstep;
            const char* a2 = last ? nA : cA + (size_t)(t + 2) * kstep; const char* b2 = last ? nB : cB + (size_t)(t + 2) * kstep;
            const char* a3 = a2 + kstep; const char* b3 = b2 + kstep;
            if (last && has_next) S.a_ready(nxt);
            if constexpr (SP2) {
            PG8_LDB(B0, 0, 0); PG8_LDB(B1, 0, 1); PG8_SCHED; PG8_LDA(At, 0, 0); PG8_STAGE(PG8_SA(1, 1), a1 + hstepA, voffA);
            PG8_WAIT_V(8); PG8_WAIT_L(0); PG8_BAR; PG8_MMA(0, 0, At, B0); PG8_MMA(0, 1, At, B1); PG8_BAR; PG8_SCHED;
            PG8_LDA(At, 0, 1); PG8_STAGE(PG8_SB(0, 0), b2, voffB); PG8_STAGE(PG8_SB(0, 1), b2 + hstepB, voffB); PG8_STAGE(PG8_SA(0, 0), a2, voffA);
            PG8_WAIT_V(8); PG8_WAIT_L(0); PG8_BAR; PG8_MMA(1, 0, At, B0); PG8_MMA(1, 1, At, B1); PG8_BAR; PG8_SCHED;
            PG8_LDB(B0, 1, 0); PG8_LDB(B1, 1, 1); PG8_SCHED; PG8_LDA(At, 1, 0); PG8_STAGE(PG8_SA(0, 1), a2 + hstepA, voffA);
            PG8_WAIT_V(8); PG8_WAIT_L(0); PG8_BAR; PG8_MMA(0, 0, At, B0); PG8_MMA(0, 1, At, B1); PG8_BAR; PG8_SCHED;
            PG8_LDA(At, 1, 1); PG8_STAGE(PG8_SB(1, 0), b3, voffB); PG8_STAGE(PG8_SB(1, 1), b3 + hstepB, voffB); PG8_STAGE(PG8_SA(1, 0), a3, voffA);
            PG8_WAIT_V(8); PG8_WAIT_L(0); PG8_BAR; PG8_MMA(1, 0, At, B0); PG8_MMA(1, 1, At, B1); PG8_BAR; PG8_SCHED;
            } else {
            PG8_LDB(B0, 0, 0); PG8_SCHED; PG8_LDA(At, 0, 0); PG8_STAGE(PG8_SA(1, 1), a1 + hstepA, voffA);
            PG8_WAIT_L(8); PG8_BAR; PG8_WAIT_L(0); PG8_MMA(0, 0, At, B0); PG8_BAR; PG8_SCHED;
            PG8_LDB(B1, 0, 1); PG8_STAGE(PG8_SB(0, 0), b2, voffB);
            PG8_BAR; PG8_WAIT_L(0); PG8_MMA(0, 1, At, B1); PG8_BAR;
            PG8_LDA(At, 0, 1); PG8_STAGE(PG8_SA(0, 0), a2, voffA);
            PG8_BAR; PG8_WAIT_L(0); PG8_MMA(1, 0, At, B0); PG8_BAR; PG8_SCHED;
            PG8_STAGE(PG8_SB(0, 1), b2 + hstepB, voffB);
            PG8_WAIT_V(6); PG8_BAR; PG8_MMA(1, 1, At, B1); PG8_BAR;
            PG8_LDB(B0, 1, 0); PG8_SCHED; PG8_LDA(At, 1, 0); PG8_STAGE(PG8_SA(0, 1), a2 + hstepA, voffA);
            PG8_WAIT_L(8); PG8_BAR; PG8_WAIT_L(0); PG8_MMA(0, 0, At, B0); PG8_BAR; PG8_SCHED;
            PG8_LDB(B1, 1, 1); PG8_STAGE(PG8_SB(1, 0), b3, voffB);
            PG8_BAR; PG8_WAIT_L(0); PG8_MMA(0, 1, At, B1); PG8_BAR;
            PG8_LDA(At, 1, 1); PG8_STAGE(PG8_SA(1, 0), a3, voffA);
            PG8_BAR; PG8_WAIT_L(0); PG8_MMA(1, 0, At, B0); PG8_BAR; PG8_SCHED;
            PG8_STAGE(PG8_SB(1, 1), b3 + hstepB, voffB);
            PG8_WAIT_V(6); PG8_BAR; PG8_MMA(1, 1, At, B1); PG8_BAR;
            }
        }
        if constexpr (ALIGN_EPI) { if (wr == 0) PG8_BAR; }
        if constexpr (!Epi::AFTER_DRAIN) { E(acc, cur, wr, wc, fr, fq); S.done(cur); }
        if (!has_next) break;
#pragma unroll
        for (int a = 0; a < 2; ++a)
#pragma unroll
            for (int b = 0; b < 2; ++b)
#pragma unroll
                for (int m = 0; m < 4; ++m)
#pragma unroll
                    for (int n = 0; n < 2; ++n) acc[a][b][m][n] = (f32x4){0.f, 0.f, 0.f, 0.f};
        cur = nxt; cA = nA; cB = nB; ++ui;
        if constexpr (ALIGN_EPI) { if (wr == 1) PG8_BAR; }
    }
    PG8_WAIT_V(0);
    if constexpr (!ALIGN_EPI) { if (wr == 0) PG8_BAR; }
    PG8_BAR;
    if constexpr (Epi::AFTER_DRAIN) { E.fused(acc, cur, wr, wc, fr, fq, lds, wid, lane); S.done(cur); }
#undef PG8_SA
#undef PG8_SB
#undef PG8_STAGE
#undef PG8_LDA
#undef PG8_LDB
#undef PG8_MMA
#undef PG8_WAIT_V
#undef PG8_WAIT_L
#undef PG8_BAR
#undef PG8_SCHED
}
}
#ifndef GEMM_SP2
#define GEMM_SP2 true
#endif
#ifndef GEMM_ALIGN
#define GEMM_ALIGN true
#endif
#ifndef SINGLE_LAUNCH
#define SINGLE_LAUNCH 1
#endif
constexpr int NB = 4, SEQ = 4096, DM = 2048, MTOK = NB * SEQ;
constexpr int NIN = 6656;
constexpr float EPS = 1e-6f, LOG2E = 1.4426950408889634f;
constexpr int E_QA = 0, E_KA = 1024, E_VA = 2048, E_GA = 3072, E_CQ = 4096, E_CKV = 4864, E_GB = 5376, E_KR = 6400;
constexpr int O_QC = 0, O_KC = 1024, O_VC = 2048, O_GC = 3072, O_QD = 4096, O_KD = 5120, O_VD = 5376, O_GD = 5632;
constexpr int QMW = 1536, KVW = 2048;
constexpr int SSLD = 20;

constexpr size_t MiB = 1u << 20;
constexpr size_t WS_CTL = 0, CTL_ZERO_BYTES = 64 * 1024;
constexpr size_t WS_TAB = 1 * MiB;
constexpr size_t WS_RSS = 2 * MiB;
constexpr size_t WS_SSQ = 4 * MiB;
constexpr size_t WS_CONST = 6 * MiB;
constexpr size_t WS_WIN0 = 8 * MiB, WS_WOUT0 = 34 * MiB, WS_WUQ = 42 * MiB, WS_WUKV = 45 * MiB, WS_WIN1 = 47 * MiB, WS_WOUT1 = 73 * MiB;
constexpr size_t WS_XN = 96 * MiB;
constexpr size_t WS_KVM = WS_XN;
constexpr size_t WS_H1 = 160 * MiB;
constexpr size_t WS_MB = WS_H1;
constexpr size_t WS_QM = 368 * MiB;
constexpr size_t WS_X1B = 368 * MiB;
constexpr size_t WS_ATT = 432 * MiB;
constexpr size_t WS_KPE = 496 * MiB;
constexpr size_t WS_KG = 498 * MiB;
constexpr size_t WS_END = 506 * MiB;
constexpr int CW_BAR = 4096, CW_KMAX = 8192, CW_QCTR = 12288;

constexpr int RING_OFF = 0, RING_BYTES = 131072;
constexpr int LDSCTL_OFF = RING_BYTES, MISC_OFF = LDSCTL_OFF + 320;
constexpr int LDS_BYTES = 147456;
constexpr int NWAVES = 8;

#define GAS __attribute__((address_space(1)))
#define LAS __attribute__((address_space(3)))
typedef unsigned short bf16;
typedef unsigned v4u __attribute__((ext_vector_type(4)));
typedef unsigned v2u __attribute__((ext_vector_type(2)));
typedef float f32x4 __attribute__((ext_vector_type(4)));
typedef float f32x2 __attribute__((ext_vector_type(2)));
typedef GAS unsigned gu32;
#define RLX_AGENT __ATOMIC_RELAXED, __HIP_MEMORY_SCOPE_AGENT
#define LDS_WAIT() asm volatile("s_waitcnt lgkmcnt(0)" ::: "memory")
#define VM_WAIT() asm volatile("s_waitcnt vmcnt(0)" ::: "memory")
__device__ __forceinline__ unsigned f2bf(float f) { unsigned u = __builtin_bit_cast(unsigned, f); return (u + 0x7fffu + ((u >> 16) & 1u)) >> 16; }
__device__ __forceinline__ unsigned pk2(float lo, float hi) { return f2bf(lo) | (f2bf(hi) << 16); }
__device__ __forceinline__ float bflo(unsigned w) { return __uint_as_float(w << 16); }
__device__ __forceinline__ float bfhi(unsigned w) { return __uint_as_float(w & 0xffff0000u); }
__device__ __forceinline__ float bf1(bf16 u) { return __uint_as_float((unsigned)u << 16); }
__device__ __forceinline__ float silu(float x) { return x / (1.0f + __expf(-x)); }
__device__ __forceinline__ float wave_sum(float v) {
#pragma unroll
    for (int o = 1; o < 64; o <<= 1) v += __shfl_xor(v, o);
    return v;
}
__device__ __forceinline__ float wave_max(float v) {
#pragma unroll
    for (int o = 1; o < 64; o <<= 1) v = fmaxf(v, __shfl_xor(v, o));
    return v;
}

#define XB_TMO      128
#define XB_XCNT(j)  (256  + 64 * (j))
#define XB_XSUB(j)  (1280 + 64 * (j))
#define XB_XGEN(j)  (2304 + 64 * (j))
#define XB_TOP      3328
#define XB_TOPGEN   3392
#define XCD_BAR_WORDS 3456
#define XB_SPIN_CAP (1u << 18)

__device__ __forceinline__ unsigned xb_ld(unsigned* p)              { return __hip_atomic_load(p, __ATOMIC_RELAXED, __HIP_MEMORY_SCOPE_AGENT); }
__device__ __forceinline__ unsigned xb_add(unsigned* p, unsigned v) { return __hip_atomic_fetch_add(p, v, __ATOMIC_RELAXED, __HIP_MEMORY_SCOPE_AGENT); }
__device__ __forceinline__ unsigned xb_xcc_id() { return (unsigned)__builtin_amdgcn_s_getreg((3 << 11) | 20) & 0xFu; }
#define XB_SPIN(cond, bar) do { unsigned _sp = 0; while (cond) { __builtin_amdgcn_s_sleep(1); \
    if ((++_sp & 255u) == 0u) { if (xb_ld(&(bar)[XB_TMO])) break; if (_sp > XB_SPIN_CAP) { atomicAdd(&(bar)[XB_TMO], 1u); break; } } } } while (0)

struct XcdBarrier {
    unsigned* bar; unsigned x;
    volatile LAS unsigned* st;
};

__device__ __forceinline__ XcdBarrier xcd_barrier_post(unsigned* bar, volatile LAS unsigned* st) {
    XcdBarrier b; b.bar = bar; b.x = xb_xcc_id(); b.st = st;
    if (threadIdx.x == 0) (void)xb_add(&bar[XB_XCNT(b.x)], 1u);
    return b;
}
__device__ __forceinline__ void xcd_barrier_complete(unsigned* bar, unsigned x, unsigned& nloc, unsigned& nx) {
    const unsigned G = gridDim.x * gridDim.y * gridDim.z;
    unsigned sum, cnt, mine, sp = 0u;
    for (;;) {
        sum = 0u; cnt = 0u; mine = 0u;
#pragma unroll
        for (unsigned j = 0; j < 16; ++j) { const unsigned c = xb_ld(&bar[XB_XCNT(j)]); sum += c; cnt += (c > 0u) ? 1u : 0u; mine = (j == x) ? c : mine; }
        if (sum == G) break;
        __builtin_amdgcn_s_sleep(1);
        if ((++sp & 255u) == 0u) { if (xb_ld(&bar[XB_TMO])) break; if (sp > XB_SPIN_CAP) { atomicAdd(&bar[XB_TMO], 1u); break; } }
    }
    nloc = mine > 0u ? mine : 1u; nx = cnt > 0u ? cnt : 1u;
}

__device__ __forceinline__ void xcd_barrier(const XcdBarrier& b) {
    asm volatile("s_waitcnt vmcnt(0)" ::: "memory");
    __syncthreads();
    if (threadIdx.x == 0) {
        unsigned* bar = b.bar;
        __builtin_amdgcn_s_waitcnt(0);
        unsigned nloc = b.st[0], nx = b.st[1];
        if (nloc == 0u) { xcd_barrier_complete(bar, b.x, nloc, nx); b.st[0] = nloc; b.st[1] = nx; }
        const unsigned old = xb_add(&bar[XB_XSUB(b.x)], 1u);
        const unsigned gen = old / nloc;
        if (old + 1u == (gen + 1u) * nloc) {
            __builtin_amdgcn_fence(__ATOMIC_RELEASE, "agent");
            asm volatile("s_waitcnt vmcnt(0)" ::: "memory");
            const unsigned og = xb_add(&bar[XB_TOP], 1u);
            const unsigned tg = og / nx;
            if (og + 1u == (tg + 1u) * nx) xb_add(&bar[XB_TOPGEN], 1u);
            else XB_SPIN(xb_ld(&bar[XB_TOPGEN]) == tg, bar);
            __builtin_amdgcn_fence(__ATOMIC_ACQUIRE, "agent");
            xb_add(&bar[XB_XGEN(b.x)], 1u);
            asm volatile("s_waitcnt vmcnt(0)" ::: "memory");
        } else {
            XB_SPIN(xb_ld(&bar[XB_XGEN(b.x)]) == gen, bar);
            __builtin_amdgcn_fence(__ATOMIC_ACQUIRE, "agent");
            asm volatile("s_waitcnt vmcnt(0)" ::: "memory");
        }
    }
    __syncthreads();
}


#ifndef PAD_P0
#define PAD_P0 0
#endif
#ifndef PAD_P3
#define PAD_P3 0
#endif
#ifndef PAD_P4
#define PAD_P4 0
#endif
#ifndef PAD_P7
#define PAD_P7 0
#endif
#define PAD_STR2(x) #x
#define PAD_STR(x) PAD_STR2(x)
#ifndef FA_PVP
#define FA_PVP 0
#endif
#ifndef FA_SETPRIO
#define FA_SETPRIO 0
#endif
#ifndef FA_PVDEP
#define FA_PVDEP 0
#endif
#ifndef FA_NOSB
#define FA_NOSB 0
#endif
#ifndef FA_MBIAS
#define FA_MBIAS 1
#endif
namespace fa {
typedef short bf16x8 __attribute__((ext_vector_type(8)));
typedef short s16x4 __attribute__((ext_vector_type(4)));
typedef float f32x16 __attribute__((ext_vector_type(16)));
typedef unsigned u32x4 __attribute__((ext_vector_type(4)));
constexpr int R_V = 0, R_K1 = 49152, R_K2 = 98304;
constexpr int L_WS = 122880, L_RPB = 124928, L_QMAX = 127488, L_END = 127552;
constexpr int SHM_V = 16384, SHM_K1 = 16384, SHM_K2 = 8192;
constexpr float THR2 = 8.f;
#define FA_SBAR() __builtin_amdgcn_sched_barrier(0)
#define FA_KSWZ(row, colB) ((row) * 256 + ((colB) ^ (((row) & 15) << 4)))
#define FA_K2SWZ(row, ch) ((row) * 128 + ((((ch) ^ ((row) >> 1)) & 7) << 4))
__device__ __forceinline__ int crow(int r, int hi) { return (r & 3) + 8 * (r >> 2) + 4 * hi; }
template <int X> __device__ __forceinline__ float swz_xor(float v) { return __int_as_float(__builtin_amdgcn_ds_swizzle(__float_as_int(v), (X << 10) | 0x1f)); }
__device__ __forceinline__ unsigned cvtpk(float lo, float hi) { unsigned r; asm volatile("v_cvt_pk_bf16_f32 %0, %1, %2" : "=v"(r) : "v"(lo), "v"(hi)); return r; }
typedef __bf16 bf2c __attribute__((ext_vector_type(2))); typedef float f2c __attribute__((ext_vector_type(2)));
__device__ __forceinline__ unsigned cvtpk_c(float lo, float hi) { return __builtin_bit_cast(unsigned, __builtin_convertvector((f2c){lo, hi}, bf2c)); }
__device__ __forceinline__ bf16x8 pack8(const float* f) { u32x4 w = {cvtpk(f[0], f[1]), cvtpk(f[2], f[3]), cvtpk(f[4], f[5]), cvtpk(f[6], f[7])}; return __builtin_bit_cast(bf16x8, w); }
__device__ __forceinline__ void unpack8(bf16x8 v, float* f) { const u32x4 w = __builtin_bit_cast(u32x4, v);
    f[0] = __uint_as_float(w.x << 16); f[1] = __uint_as_float(w.x & 0xffff0000u); f[2] = __uint_as_float(w.y << 16); f[3] = __uint_as_float(w.y & 0xffff0000u);
    f[4] = __uint_as_float(w.z << 16); f[5] = __uint_as_float(w.z & 0xffff0000u); f[6] = __uint_as_float(w.w << 16); f[7] = __uint_as_float(w.w & 0xffff0000u); }

__device__ __forceinline__ void partialSM(f32x16& p0, f32x16& p1, float& m_reg, float& alpha) {
    float pmax = p0[0];
#pragma unroll
    for (int r = 1; r < 16; ++r) pmax = fmaxf(pmax, p0[r]);
#pragma unroll
    for (int r = 0; r < 16; ++r) pmax = fmaxf(pmax, p1[r]);
    { auto rr = __builtin_amdgcn_permlane32_swap(__float_as_uint(pmax), __float_as_uint(pmax), false, false); pmax = fmaxf(__uint_as_float(rr[0]), __uint_as_float(rr[1])); }
    const bool keep = __all(pmax - m_reg <= THR2); const float mx = fmaxf(m_reg, pmax), mn = keep ? m_reg : mx;
    alpha = keep ? 1.f : __builtin_amdgcn_exp2f(m_reg - mx); m_reg = mn;
#pragma unroll
    for (int r = 0; r < 16; ++r) { p0[r] -= mn; p1[r] -= mn; }
#pragma unroll
    for (int r = 0; r < 16; ++r) p0[r] = __builtin_amdgcn_exp2f(p0[r]);
}
__device__ __forceinline__ void finishSM(f32x16& p0, f32x16& p1, float alpha, float& l_reg, bf16x8& pa0, bf16x8& pa1, bf16x8& pa2, bf16x8& pa3) {
#pragma unroll
    for (int r = 0; r < 16; ++r) p1[r] = __builtin_amdgcn_exp2f(p1[r]);
    float ps = 0;
#pragma unroll
    for (int r = 0; r < 16; ++r) ps += p0[r];
#pragma unroll
    for (int r = 0; r < 16; ++r) ps += p1[r];
    { auto rr = __builtin_amdgcn_permlane32_swap(__float_as_uint(ps), __float_as_uint(ps), false, false); ps = __uint_as_float(rr[0]) + __uint_as_float(rr[1]); }
    l_reg = l_reg * alpha + ps;
#define FA_PK4(P, BASE, OUT) do { unsigned a0 = cvtpk(P[BASE + 0], P[BASE + 1]), a1 = cvtpk(P[BASE + 2], P[BASE + 3]);   \
    unsigned b0 = cvtpk(P[BASE + 4], P[BASE + 5]), b1 = cvtpk(P[BASE + 6], P[BASE + 7]);                              \
    auto r0 = __builtin_amdgcn_permlane32_swap(a0, b0, false, false); auto r1 = __builtin_amdgcn_permlane32_swap(a1, b1, false, false); \
    u32x4 w = {r0[0], r1[0], r0[1], r1[1]}; OUT = __builtin_bit_cast(bf16x8, w); } while (0)
    FA_PK4(p0, 0, pa0); FA_PK4(p0, 8, pa1); FA_PK4(p1, 0, pa2); FA_PK4(p1, 8, pa3);
#undef FA_PK4
}
template <int D1, int D2>
__device__ __forceinline__ void qkt(f32x16& p0, f32x16& p1, const char* K1s, const char* K2s, const bf16x8* qr, int r32, int hi) {
    if (FA_SETPRIO) __builtin_amdgcn_s_setprio(1);
#pragma unroll
    for (int d0 = 0; d0 < D1 / 16; ++d0) { const int cb = (d0 * 16 + hi * 8) * 2;
        const bf16x8 b0 = *reinterpret_cast<const bf16x8*>(K1s + FA_KSWZ(r32, cb));
        const bf16x8 b1 = *reinterpret_cast<const bf16x8*>(K1s + FA_KSWZ(32 + r32, cb));
        p0 = __builtin_amdgcn_mfma_f32_32x32x16_bf16(b0, qr[d0], p0, 0, 0, 0);
        p1 = __builtin_amdgcn_mfma_f32_32x32x16_bf16(b1, qr[d0], p1, 0, 0, 0); }
#pragma unroll
    for (int d0 = 0; d0 < D2 / 16; ++d0) { const int ch = 2 * d0 + hi;
        const bf16x8 b0 = *reinterpret_cast<const bf16x8*>(K2s + FA_K2SWZ(r32, ch));
        const bf16x8 b1 = *reinterpret_cast<const bf16x8*>(K2s + FA_K2SWZ(32 + r32, ch));
        p0 = __builtin_amdgcn_mfma_f32_32x32x16_bf16(b0, qr[D1 / 16 + d0], p0, 0, 0, 0);
        p1 = __builtin_amdgcn_mfma_f32_32x32x16_bf16(b1, qr[D1 / 16 + d0], p1, 0, 0, 0); }
    if (FA_SETPRIO) __builtin_amdgcn_s_setprio(0);
}
__device__ __forceinline__ int v_st(int k, int c) { const int kk = (k & ~0xC) | ((k & 4) << 1) | ((k & 8) >> 1); return ((kk >> 3) * 4 + (c >> 5)) * 512 + ((kk & 7) * 32 + (c & 31)) * 2; }
__device__ __forceinline__ int v_rd_base(int lane) { return ((lane & 3) << 3) | (((lane >> 2) & 3) << 6) | (((lane >> 4) & 1) << 5) | (((lane >> 5) & 1) << 8); }
constexpr int v_rd_off(int d0, int ks, int half) { return d0 * 512 + ks * 4096 + half * 2048; }
template <int OFF> __device__ __forceinline__ s16x4 tr_read(int vb) { s16x4 r; asm volatile("ds_read_b64_tr_b16 %0, %1 offset:%2" : "=&v"(r) : "v"(vb), "i"(OFF) : "memory"); return r; }
template <int D0> __device__ __forceinline__ void pv_one(f32x16& od, int vb, bf16x8 pa0, bf16x8 pa1, bf16x8 pa2, bf16x8 pa3) {
    s16x4 l0 = tr_read<v_rd_off(D0, 0, 0)>(vb), h0 = tr_read<v_rd_off(D0, 0, 1)>(vb), l1 = tr_read<v_rd_off(D0, 1, 0)>(vb), h1 = tr_read<v_rd_off(D0, 1, 1)>(vb);
    s16x4 l2 = tr_read<v_rd_off(D0, 2, 0)>(vb), h2 = tr_read<v_rd_off(D0, 2, 1)>(vb), l3 = tr_read<v_rd_off(D0, 3, 0)>(vb), h3 = tr_read<v_rd_off(D0, 3, 1)>(vb);
    if (FA_PVDEP) asm volatile("s_waitcnt lgkmcnt(0)" : "+v"(l0), "+v"(h0), "+v"(l1), "+v"(h1), "+v"(l2), "+v"(h2), "+v"(l3), "+v"(h3) :: "memory");
    else { asm volatile("s_waitcnt lgkmcnt(0)" ::: "memory"); FA_SBAR(); }
    if (FA_SETPRIO) __builtin_amdgcn_s_setprio(1);
#define FA_PK(L, H) (bf16x8){L[0], L[1], L[2], L[3], H[0], H[1], H[2], H[3]}
    od = __builtin_amdgcn_mfma_f32_32x32x16_bf16(pa0, FA_PK(l0, h0), od, 0, 0, 0);
    od = __builtin_amdgcn_mfma_f32_32x32x16_bf16(pa1, FA_PK(l1, h1), od, 0, 0, 0);
    od = __builtin_amdgcn_mfma_f32_32x32x16_bf16(pa2, FA_PK(l2, h2), od, 0, 0, 0);
    od = __builtin_amdgcn_mfma_f32_32x32x16_bf16(pa3, FA_PK(l3, h3), od, 0, 0, 0);
    if (FA_SETPRIO) __builtin_amdgcn_s_setprio(0);
#undef FA_PK
}
__device__ __forceinline__ void pv_d0(f32x16* o, int vb, bf16x8 pa0, bf16x8 pa1, bf16x8 pa2, bf16x8 pa3) {
    pv_one<0>(o[0], vb, pa0, pa1, pa2, pa3); pv_one<1>(o[1], vb, pa0, pa1, pa2, pa3); pv_one<2>(o[2], vb, pa0, pa1, pa2, pa3); pv_one<3>(o[3], vb, pa0, pa1, pa2, pa3);
}

typedef __amdgpu_buffer_rsrc_t rsrc_t;
__device__ __forceinline__ rsrc_t mk_rsrc(const void* p, unsigned bytes) { return __builtin_amdgcn_make_buffer_rsrc((void*)p, 0, (int)bytes, 0x00020000); }
constexpr unsigned OUT_BYTES = (unsigned)MTOK * DM * 4u, WS_BYTES = (unsigned)WS_END;
constexpr unsigned OF_H1 = (unsigned)WS_H1, OF_ATT = (unsigned)WS_ATT, OF_KVM = (unsigned)WS_KVM, OF_KPE = (unsigned)WS_KPE, OF_KG = (unsigned)WS_KG;
typedef int i32x4 __attribute__((ext_vector_type(4)));
__device__ __forceinline__ bf16x8 bload16(rsrc_t r, unsigned voff, unsigned soff) { return __builtin_bit_cast(bf16x8, __builtin_amdgcn_raw_buffer_load_b128(r, voff, soff, 0)); }
template <int D0> __device__ __forceinline__ void pv_rd(int vb, s16x4 (&l)[4], s16x4 (&h)[4]) {
    l[0] = tr_read<v_rd_off(D0, 0, 0)>(vb); h[0] = tr_read<v_rd_off(D0, 0, 1)>(vb); l[1] = tr_read<v_rd_off(D0, 1, 0)>(vb); h[1] = tr_read<v_rd_off(D0, 1, 1)>(vb);
    l[2] = tr_read<v_rd_off(D0, 2, 0)>(vb); h[2] = tr_read<v_rd_off(D0, 2, 1)>(vb); l[3] = tr_read<v_rd_off(D0, 3, 0)>(vb); h[3] = tr_read<v_rd_off(D0, 3, 1)>(vb);
}
__device__ __forceinline__ void pv_mm(f32x16& od, const s16x4 (&l)[4], const s16x4 (&h)[4], bf16x8 pa0, bf16x8 pa1, bf16x8 pa2, bf16x8 pa3) {
#define FA_PK(L, H) (bf16x8){L[0], L[1], L[2], L[3], H[0], H[1], H[2], H[3]}
    od = __builtin_amdgcn_mfma_f32_32x32x16_bf16(pa0, FA_PK(l[0], h[0]), od, 0, 0, 0);
    od = __builtin_amdgcn_mfma_f32_32x32x16_bf16(pa1, FA_PK(l[1], h[1]), od, 0, 0, 0);
    od = __builtin_amdgcn_mfma_f32_32x32x16_bf16(pa2, FA_PK(l[2], h[2]), od, 0, 0, 0);
    od = __builtin_amdgcn_mfma_f32_32x32x16_bf16(pa3, FA_PK(l[3], h[3]), od, 0, 0, 0);
#undef FA_PK
}
__device__ __forceinline__ void pv_d0p(f32x16* o, int vb, bf16x8 pa0, bf16x8 pa1, bf16x8 pa2, bf16x8 pa3) {
    s16x4 la[4], ha[4], lb[4], hb[4];
    pv_rd<0>(vb, la, ha); pv_rd<1>(vb, lb, hb);
    asm volatile("s_waitcnt lgkmcnt(8)" ::: "memory"); FA_SBAR(); pv_mm(o[0], la, ha, pa0, pa1, pa2, pa3); FA_SBAR();
    pv_rd<2>(vb, la, ha);
    asm volatile("s_waitcnt lgkmcnt(8)" ::: "memory"); FA_SBAR(); pv_mm(o[1], lb, hb, pa0, pa1, pa2, pa3); FA_SBAR();
    pv_rd<3>(vb, lb, hb);
    asm volatile("s_waitcnt lgkmcnt(8)" ::: "memory"); FA_SBAR(); pv_mm(o[2], la, ha, pa0, pa1, pa2, pa3); FA_SBAR();
    asm volatile("s_waitcnt lgkmcnt(0)" ::: "memory"); FA_SBAR(); pv_mm(o[3], lb, hb, pa0, pa1, pa2, pa3);
}

struct CoreP {
    rsrc_t K1; unsigned oK1;
    rsrc_t K2; unsigned oK2;
    rsrc_t V; unsigned oV;
    int NT;
    float slope2; int qrel0;
    int R0, rlo;
};
template <int MODE, int D1, int D2, int LDK1, int LDK2, int LDV, bool PVP = false>
__device__ __forceinline__ void attn_core_r(const bf16x8* qr, const CoreP& P, f32x16 (&o)[4], float& l_reg, char* lds) {
    const int tid = fresh_tid(), lane = tid & 63, wid = __builtin_amdgcn_readfirstlane(tid >> 6), r32 = lane & 31, hi = lane >> 5;
    char* V_lds = lds + R_V; char* K1_lds = lds + R_K1; char* K2_lds = lds + R_K2;
    float* wsf = (float*)(lds + L_WS) + wid * 64; float* al_l = wsf + 32;
    float m_reg = -1e30f; l_reg = 0.f;
#pragma unroll
    for (int d = 0; d < 4; ++d) o[d] = f32x16{};
    const int sr = tid >> 4, sc = (tid & 15) * 8, vst0 = v_st(sr, sc), vst1 = v_st(32 + sr, sc), k2r = tid >> 3, k2c = tid & 7;
    struct { bf16x8 vs0, vs1, ka0, ka1, kb; } st;
    const unsigned voffV = (unsigned)((sr * LDV + sc) * 2), voffK1 = (unsigned)((sr * LDK1 + sc) * 2), voffK2 = (unsigned)((k2r * LDK2 + k2c * 8) * 2);
#define FR_SLOAD(k0) do { const unsigned vo_ = P.oV + (unsigned)(k0) * (LDV * 2); st.vs0 = bload16(P.V, voffV, vo_); st.vs1 = bload16(P.V, voffV, vo_ + 32 * LDV * 2); \
    if constexpr (D1 > 0) { const unsigned ko_ = P.oK1 + (unsigned)(k0) * (LDK1 * 2); st.ka0 = bload16(P.K1, voffK1, ko_); st.ka1 = bload16(P.K1, voffK1, ko_ + 32 * LDK1 * 2); } \
    if constexpr (D2 > 0) { st.kb = bload16(P.K2, voffK2, P.oK2 + (unsigned)(k0) * (LDK2 * 2)); } } while (0)
#define FR_SWRITE(sl) do { *(bf16x8*)(V_lds + (sl) * SHM_V + vst0) = st.vs0; *(bf16x8*)(V_lds + (sl) * SHM_V + vst1) = st.vs1; \
    if constexpr (D1 > 0) { *(bf16x8*)(K1_lds + (sl) * SHM_K1 + FA_KSWZ(sr, sc * 2)) = st.ka0; *(bf16x8*)(K1_lds + (sl) * SHM_K1 + FA_KSWZ(32 + sr, sc * 2)) = st.ka1; } \
    if constexpr (D2 > 0) { *(bf16x8*)(K2_lds + (sl) * SHM_K2 + FA_K2SWZ(k2r, k2c)) = st.kb; } } while (0)
#define FR_RESC(a) do { if (__any((a) < 1.f)) { if (hi == 0) al_l[r32] = (a); asm volatile("s_waitcnt lgkmcnt(0)" ::: "memory"); \
    _Pragma("unroll") for (int d = 0; d < 4; ++d) _Pragma("unroll") for (int r = 0; r < 16; ++r) o[d][r] *= al_l[crow(r, hi)]; } } while (0)
    const int qw = P.qrel0 + wid * 32, qrel = qw + r32;
    const unsigned lm0 = hi ? 0u : 0xffffffffu;
    const float s_hi_f = __uint_as_float(cvtpk_c(P.slope2, 0.f) << 16), s_lo_f = P.slope2 - s_hi_f;
    const unsigned ws_pk = cvtpk_c(s_hi_f, s_lo_f);
    bf16x8 ab0, ab1;
    { const unsigned kk0_ = cvtpk_c((float)r32, (float)r32), kk1_ = cvtpk_c((float)(32 + r32), (float)(32 + r32)), s256_ = cvtpk_c(256.f * s_hi_f, 256.f * s_lo_f);
      const u32x4 a0_ = {kk0_ & lm0, s256_ & lm0, ws_pk & lm0, 0u}, a1_ = {kk1_ & lm0, s256_ & lm0, ws_pk & lm0, 0u}; ab0 = __builtin_bit_cast(bf16x8, a0_); ab1 = __builtin_bit_cast(bf16x8, a1_); }
    const int na_rq = P.R0 + (wid >> 1), na_lo = min(max(na_rq - 4, 0), 56) - P.rlo;
#define FR_INB(t) true
  \
  \
#define FR_BIAS(P0, P1, t) do { if constexpr (MODE == 0) { const int k0_ = (t) * 64; \
    if (FA_MBIAS && (k0_ + 63 <= qw || k0_ >= qw + 31)) { const bool left_ = (k0_ + 63 <= qw); const int d_ = qrel - k0_; \
        float na_ = (float)(d_ >> 8), nb_ = (float)(d_ & 255); if (left_) { na_ = -na_; nb_ = -nb_; } \
        const unsigned w0_ = left_ ? ws_pk : (ws_pk ^ 0x80008000u), w1_ = cvtpk_c(na_, na_), w2_ = cvtpk_c(nb_, nb_); \
        const u32x4 bw_ = {w0_ & lm0, w1_ & lm0, w2_ & lm0, 0u}; const bf16x8 bb_ = __builtin_bit_cast(bf16x8, bw_); \
        P0 = __builtin_amdgcn_mfma_f32_32x32x16_bf16(ab0, bb_, f32x16{}, 0, 0, 0); P1 = __builtin_amdgcn_mfma_f32_32x32x16_bf16(ab1, bb_, f32x16{}, 0, 0, 0); } \
    else { float fb = (float)((t) * 64 + 4 * hi - qrel); asm volatile("" : "+v"(fb)); \
        _Pragma("unroll") for (int r = 0; r < 16; ++r) { const float c = (float)((r & 3) + 8 * (r >> 2)); P0[r] = -P.slope2 * fabsf(fb + c); P1[r] = -P.slope2 * fabsf(fb + 32.f + c); } } } } while (0)
#define FR_QKT(P0, P1, sl, t) do { \
    if constexpr (MODE != 0) { P0 = f32x16{}; P1 = f32x16{}; } \
    qkt<D1, D2>(P0, P1, K1_lds + (sl) * SHM_K1, K2_lds + (sl) * SHM_K2, qr, r32, hi); \
    if constexpr (MODE == 3) { const int kr = P.rlo + (t); int l3 = lane; asm volatile("" : "+v"(l3)); \
        const int hi3 = l3 >> 5, cq3 = (wid & 1) * 32 + (l3 & 31), c03 = min(max(cq3 - 8, 0), 48); \
        if ((t) < na_lo || (t) >= na_lo + 8) { _Pragma("unroll") for (int r = 0; r < 16; ++r) { P0[r] = -INFINITY; P1[r] = -INFINITY; } } \
        else { const float* rp = (const float*)(lds + L_RPB) + 64 + (kr - na_rq + 7) * 32 - cq3 + 15 + 4 * hi3; const int tb = 4 * hi3 - c03; \
        _Pragma("unroll") for (int r = 0; r < 16; ++r) { const int cr = (r & 3) + 8 * (r >> 2); \
            P0[r] = ((unsigned)(tb + cr) < 16u) ? P0[r] + rp[cr] : -INFINITY; P1[r] = ((unsigned)(tb + cr + 32) < 16u) ? P1[r] + rp[cr + 32] : -INFINITY; } } } \
    } while (0)
    f32x16 pA0, pA1, pB0, pB1; float alA = 1.f, alB = 1.f; bf16x8 pa0, pa1, pa2, pa3; const int NT = P.NT;
    int s_prev = 0, s_cur = 1, s_next = 2;
#define FR_HALF(t, X0, X1, ALX, Y0, Y1, ALY) do { \
    FA_SBAR(); if (FR_INB(t)) FR_QKT(X0, X1, s_cur, t); \
    if (FR_INB((t) - 1)) finishSM(Y0, Y1, ALY, l_reg, pa0, pa1, pa2, pa3); if (!(FA_NOSB & 1)) FA_SBAR(); \
    if ((t) + 1 < NT) { FR_SWRITE(s_next); if ((t) + 2 < NT) FR_SLOAD(((t) + 2) * 64); } if (!(FA_NOSB & 2)) FA_SBAR(); \
    FR_BIAS(Y0, Y1, (t) + 1); \
    if (FR_INB((t) - 1)) { if constexpr (PVP) pv_d0p(o, vb0 + s_prev * SHM_V, pa0, pa1, pa2, pa3); else pv_d0(o, vb0 + s_prev * SHM_V, pa0, pa1, pa2, pa3); } \
    if (FR_INB(t)) { partialSM(X0, X1, m_reg, ALX); FR_RESC(ALX); } \
    __syncthreads(); { const int s_ = s_prev; s_prev = s_cur; s_cur = s_next; s_next = s_; } } while (0)
#define FR_TAIL(Y0, Y1, ALY) do { if (FR_INB(NT - 1)) { finishSM(Y0, Y1, ALY, l_reg, pa0, pa1, pa2, pa3); FA_SBAR(); const int vb0 = (int)(uintptr_t)V_lds + v_rd_base(fresh_tid() & 63);     if constexpr (PVP) pv_d0p(o, vb0 + s_prev * SHM_V, pa0, pa1, pa2, pa3); else pv_d0(o, vb0 + s_prev * SHM_V, pa0, pa1, pa2, pa3); } } while (0)
    FR_SLOAD(0); FR_SWRITE(0);
    if (NT > 1) { FR_SLOAD(64); FR_SWRITE(1); }
    __syncthreads();
    FR_BIAS(pA0, pA1, 0);
    if (FR_INB(0)) { FR_QKT(pA0, pA1, 0, 0); partialSM(pA0, pA1, m_reg, alA); }
    FR_BIAS(pB0, pB1, 1);
    if (NT > 2) FR_SLOAD(128);
    const int vb0 = (int)(uintptr_t)V_lds + v_rd_base(fresh_tid() & 63);
    int t = 1;
#pragma clang loop unroll(disable)
    for (; t + 1 < NT; t += 2) { FR_HALF(t, pB0, pB1, alB, pA0, pA1, alA); FR_HALF(t + 1, pA0, pA1, alA, pB0, pB1, alB); }
    if (t < NT) { FR_HALF(t, pB0, pB1, alB, pA0, pA1, alA); FR_TAIL(pB0, pB1, alB); }
    else { { const int s_ = s_prev; (void)s_; } FR_TAIL(pA0, pA1, alA); }
    asm volatile("s_waitcnt vmcnt(0) lgkmcnt(0)" ::: "memory"); __syncthreads();
#undef FR_SLOAD
#undef FR_SWRITE
#undef FR_RESC
#undef FR_INB
#undef FR_QKT
#undef FR_BIAS
#undef FR_HALF
#undef FR_TAIL
}
__device__ __forceinline__ void row_inv(float l_reg, float* rli, char* lds, int wid, int r32, int hi) {
    float* li_l = (float*)(lds + L_WS) + wid * 64;
    if (hi == 0) li_l[r32] = l_reg; asm volatile("s_waitcnt lgkmcnt(0)" ::: "memory");
#pragma unroll
    for (int r = 0; r < 16; ++r) rli[r] = __builtin_amdgcn_rcpf(li_l[crow(r, hi)]);
}
__device__ __forceinline__ float silu_f(float x) { return x * __builtin_amdgcn_rcpf(1.0f + __builtin_amdgcn_exp2f(-1.4426950408889634f * x)); }
__device__ __forceinline__ float bfv(bf16 u) { return __uint_as_float((unsigned)u << 16); }
__device__ __forceinline__ bf16 f2b(float f) { unsigned u = __builtin_bit_cast(unsigned, f); return (bf16)((u + 0x7fffu + ((u >> 16) & 1u)) >> 16); }

template <int NQ> __device__ __forceinline__ float unit_qmax2(const bf16x8* qr, char* lds, int wid) {
    float ss = 0.f;
#pragma unroll
    for (int d0 = 0; d0 < NQ; ++d0) { float f[8]; unpack8(qr[d0], f);
#pragma unroll
        for (int j = 0; j < 8; ++j) ss = fmaf(f[j], f[j], ss); }
    { auto rr = __builtin_amdgcn_permlane32_swap(__float_as_uint(ss), __float_as_uint(ss), false, false); ss = __uint_as_float(rr[0]) + __uint_as_float(rr[1]); }
    ss = fmaxf(ss, swz_xor<1>(ss)); ss = fmaxf(ss, swz_xor<2>(ss)); ss = fmaxf(ss, swz_xor<4>(ss)); ss = fmaxf(ss, swz_xor<8>(ss)); ss = fmaxf(ss, swz_xor<16>(ss));
    float* qm = (float*)(lds + L_QMAX);
    qm[wid] = ss; asm volatile("s_waitcnt lgkmcnt(0)" ::: "memory"); __syncthreads();
    float m = qm[0];
#pragma unroll
    for (int w = 1; w < 8; ++w) m = fmaxf(m, qm[w]);
    return m;
}
template <int NQ> __device__ __forceinline__ void unit_tmax(const bf16x8* qr, const bf16x8* kr, float K, float slope2, char* lds, int wid, float& tl_out, float& tr_out) {
    const int l_ = fresh_tid() & 63, r32_ = l_ & 31, hi_ = l_ >> 5;
    float ss = 0.f;
#pragma unroll
    for (int d0 = 0; d0 < NQ; ++d0) { float f[8]; unpack8(qr[d0], f);
#pragma unroll
        for (int j = 0; j < 8; ++j) ss = fmaf(f[j], f[j], ss); }
    { auto rr = __builtin_amdgcn_permlane32_swap(__float_as_uint(ss), __float_as_uint(ss), false, false); ss = __uint_as_float(rr[0]) + __uint_as_float(rr[1]); }
    f32x16 p = {};
#pragma unroll
    for (int d0 = 0; d0 < NQ; ++d0) p = __builtin_amdgcn_mfma_f32_32x32x16_bf16(kr[d0], qr[d0], p, 0, 0, 0);
    float dt = -INFINITY;
#pragma unroll
    for (int r = 0; r < 16; ++r) dt = fmaxf(dt, p[r] - slope2 * fabsf((float)(crow(r, hi_) - r32_)));
    { auto rr = __builtin_amdgcn_permlane32_swap(__float_as_uint(dt), __float_as_uint(dt), false, false); dt = fmaxf(__uint_as_float(rr[0]), __uint_as_float(rr[1])); }
    const float t = sqrtf(ss) * K - dt, sr = slope2 * (float)(wid * 32 + r32_);
    float tl = t - sr, tr = t + sr;
    tl = fmaxf(tl, swz_xor<1>(tl)); tl = fmaxf(tl, swz_xor<2>(tl)); tl = fmaxf(tl, swz_xor<4>(tl)); tl = fmaxf(tl, swz_xor<8>(tl)); tl = fmaxf(tl, swz_xor<16>(tl));
    tr = fmaxf(tr, swz_xor<1>(tr)); tr = fmaxf(tr, swz_xor<2>(tr)); tr = fmaxf(tr, swz_xor<4>(tr)); tr = fmaxf(tr, swz_xor<8>(tr)); tr = fmaxf(tr, swz_xor<16>(tr));
    float* qm = (float*)(lds + L_QMAX);
    qm[wid] = tl; qm[8 + wid] = tr; asm volatile("s_waitcnt lgkmcnt(0)" ::: "memory"); __syncthreads();
    float ml = qm[0], mr = qm[8];
#pragma unroll
    for (int w = 1; w < 8; ++w) { ml = fmaxf(ml, qm[w]); mr = fmaxf(mr, qm[8 + w]); }
    tl_out = ml; tr_out = mr;
}
constexpr int KM_DIFF = 0, KM_WORDS = 64;
struct Ptrs { const bf16* H1; const bf16* QM; const bf16* KVM; const bf16* KPE; const bf16* KG; bf16* ATT; const f32x2* TAB; const float* consts; const float* subln; const float* qnorm; const float* rpb; float* dscr; const unsigned* kmax; const unsigned char* ws; };

constexpr int STG_PITCH = 272, STG_WAVE = 32 * STG_PITCH;
template <int LDG, int LDO, bool SEG2 = false>
__device__ __forceinline__ void store_gated(const f32x16 (&o)[4], const float* rli, rsrc_t G, unsigned gB, unsigned oB, char* lds) { const rsrc_t O = G;
    const int tid = fresh_tid(), lane = tid & 63, wid = __builtin_amdgcn_readfirstlane(tid >> 6), r32 = lane & 31, hi = lane >> 5;
    char* stg = lds + wid * STG_WAVE;
#pragma unroll
    for (int r = 0; r < 16; ++r)
#pragma unroll
        for (int d0 = 0; d0 < 4; ++d0) { const float v_ = o[d0][r] * rli[r]; *(bf16*)(stg + crow(r, hi) * STG_PITCH + (d0 * 32 + r32) * 2) = (bf16)cvtpk(v_, v_); }
    const int rl = lane >> 4, ch = lane & 15;
    const unsigned vG = gB + (unsigned)((rl * LDG + ch * 8) * 2), vO = oB + (unsigned)((rl * LDO + ch * 8) * 2);
    u32x4 gv[8];
#pragma unroll
    for (int i = 0; i < 8; ++i) gv[i] = __builtin_bit_cast(u32x4, __builtin_amdgcn_raw_buffer_load_b128(G, vG, ((4 * i + ((SEG2 && i >= 4) ? 48 : 0)) * LDG) * 2, 0));
    asm volatile("s_waitcnt lgkmcnt(0)" ::: "memory");
#pragma unroll
    for (int i = 0; i < 8; ++i) { const u32x4 ov = *(const u32x4*)(stg + (4 * i + rl) * STG_PITCH + ch * 16); u32x4 w;
#pragma unroll
        for (int e = 0; e < 4; ++e) { const float a0 = __uint_as_float(ov[e] << 16), a1 = __uint_as_float(ov[e] & 0xffff0000u), g0 = __uint_as_float(gv[i][e] << 16), g1 = __uint_as_float(gv[i][e] & 0xffff0000u);
            w[e] = cvtpk(a0 * silu_f(g0), a1 * silu_f(g1)); }
        __builtin_amdgcn_raw_buffer_store_b128(__builtin_bit_cast(i32x4, w), O, vO, ((4 * i + ((SEG2 && i >= 4) ? 48 : 0)) * LDO) * 2, 0); }
    __syncthreads();
}

__device__ __forceinline__ void unit_diff(const Ptrs& A, int b, int h, int qb, char* lds) {
    int tid = fresh_tid(), lane = tid & 63, wid = __builtin_amdgcn_readfirstlane(tid >> 6), r32 = lane & 31, hi = lane >> 5; long row0 = (long)b * SEQ + qb * 256 + wid * 32;
    const rsrc_t DSr = mk_rsrc(A.dscr, OUT_BYTES); unsigned voffD = 0;
    f32x16 o[4]; float l_reg; float rli[16];
#pragma clang loop unroll(disable)
    for (int mp = 0; mp < 2; ++mp) {
        bf16x8 qr[4]; const bf16* qp = A.H1 + (row0 + r32) * NIN + E_QA + h * 128 + mp * 64 + hi * 8;
#pragma unroll
        for (int d0 = 0; d0 < 4; ++d0) qr[d0] = *(const bf16x8*)(qp + d0 * 16);
        CoreP P; P.K1 = mk_rsrc(A.ws, WS_BYTES); P.oK1 = 0; P.K2 = P.K1; P.oK2 = OF_H1 + (unsigned)((b * SEQ * NIN + E_KA + h * 128 + mp * 64) * 2); P.V = P.K1; P.oV = OF_H1 + (unsigned)((b * SEQ * NIN + E_VA + h * 128) * 2);
        P.slope2 = exp2f(-(float)(h + 1)) * LOG2E; P.R0 = 0; P.rlo = 0;
        { bf16x8 kr[4]; const bf16* kp = A.H1 + (row0 + r32) * NIN + E_KA + h * 128 + mp * 64 + hi * 8;
#pragma unroll
          for (int d0 = 0; d0 < 4; ++d0) kr[d0] = *(const bf16x8*)(kp + d0 * 16);
          const float k2 = __uint_as_float(__hip_atomic_load(A.kmax + KM_DIFF + (b * 8 + h) * 2 + mp, __ATOMIC_RELAXED, __HIP_MEMORY_SCOPE_AGENT));
          float TL, TR; unit_tmax<4>(qr, kr, sqrtf(k2), P.slope2, lds, wid, TL, TR); const float mrg = 29.f - log2f(1.f - exp2f(-P.slope2));
          float dl = (TL < 2e4f) ? fmaxf(TL + mrg, 0.f) / P.slope2 : 1e6f, dr = (TR < 2e4f) ? fmaxf(TR + mrg, 255.f * P.slope2) / P.slope2 : 1e6f; dl = fminf(dl, 1e6f); dr = fminf(dr, 1e6f);
          const int q0 = qb * 256; int lo = max((int)floorf(((float)q0 - dl) * (1.f / 64)), 0), hi_t = min((int)floorf(((float)q0 + dr) * (1.f / 64)), 63);
          lo = __builtin_amdgcn_readfirstlane(lo); hi_t = __builtin_amdgcn_readfirstlane(hi_t);
          P.NT = hi_t - lo + 1; P.qrel0 = q0 - lo * 64; P.oK2 += (unsigned)(lo * 64 * NIN * 2); P.oV += (unsigned)(lo * 64 * NIN * 2); }
        attn_core_r<0, 0, 64, 8, NIN, NIN, (FA_PVP & 1) != 0>(qr, P, o, l_reg, lds);
        tid = fresh_tid(); lane = tid & 63; wid = __builtin_amdgcn_readfirstlane(tid >> 6); r32 = lane & 31; hi = lane >> 5;
        row0 = (long)b * SEQ + qb * 256 + wid * 32; voffD = (unsigned)(((int)blockIdx.x * 32768 + (wid * 32 + 4 * hi) * 128 + r32) * 4);
        row_inv(l_reg, rli, lds, wid, r32, hi);
        if (mp == 0) {
#pragma unroll
            for (int r = 0; r < 16; ++r)
#pragma unroll
                for (int d0 = 0; d0 < 4; ++d0) __builtin_amdgcn_raw_buffer_store_b32(__float_as_uint(o[d0][r] * rli[r]), DSr, voffD, (((r & 3) + 8 * (r >> 2)) * 128 + d0 * 32) * 4, 0);
        }
    }
    const float lam = A.consts[0];
    float ssq[16];
    { unsigned o0w[16][4];
#pragma unroll
      for (int r = 0; r < 16; ++r)
#pragma unroll
          for (int d0 = 0; d0 < 4; ++d0) o0w[r][d0] = __builtin_amdgcn_raw_buffer_load_b32(DSr, voffD, (((r & 3) + 8 * (r >> 2)) * 128 + d0 * 32) * 4, 16);
      asm volatile("" ::: "memory");
#pragma unroll
      for (int r = 0; r < 16; ++r) { float s = 0.f;
#pragma unroll
          for (int d0 = 0; d0 < 4; ++d0) { const float e = __uint_as_float(o0w[r][d0]) - lam * (o[d0][r] * rli[r]); o[d0][r] = e; s += e * e; }
          ssq[r] = s; } }
#pragma unroll
    for (int r = 0; r < 16; ++r) {
        ssq[r] += swz_xor<1>(ssq[r]); ssq[r] += swz_xor<2>(ssq[r]); ssq[r] += swz_xor<4>(ssq[r]); ssq[r] += swz_xor<8>(ssq[r]); ssq[r] += swz_xor<16>(ssq[r]);
        ssq[r] = 0.8f / sqrtf(ssq[r] * (1.f / 128) + EPS); }
    float sg[4];
#pragma unroll
    for (int d0 = 0; d0 < 4; ++d0) sg[d0] = A.subln[d0 * 32 + r32];
#pragma unroll
    for (int r = 0; r < 16; ++r)
#pragma unroll
        for (int d0 = 0; d0 < 4; ++d0) o[d0][r] *= sg[d0];
    store_gated<NIN, DM>(o, ssq, mk_rsrc(A.ws, WS_BYTES), OF_H1 + (unsigned)((row0 * NIN + E_GA + h * 128) * 2), OF_ATT + (unsigned)((row0 * DM + h * 128) * 2), lds);
}
__device__ __forceinline__ void unit_mla(const Ptrs& A, int b, int h, int qb, char* lds) {
    int tid = fresh_tid(), lane = tid & 63, wid = __builtin_amdgcn_readfirstlane(tid >> 6), r32 = lane & 31, hi = lane >> 5; long row0 = (long)b * SEQ + qb * 256 + wid * 32; const int tq = qb * 256 + wid * 32 + r32;
    bf16x8 qr[12]; const bf16* qp = A.QM + (row0 + r32) * QMW + h * 192 + hi * 8;
#pragma unroll
    for (int d0 = 0; d0 < 8; ++d0) qr[d0] = *(const bf16x8*)(qp + d0 * 16);
#pragma unroll
    for (int d0 = 8; d0 < 12; ++d0) { float f[8]; unpack8(*(const bf16x8*)(qp + d0 * 16), f); const f32x2* tp = A.TAB + tq * 32 + 8 * (d0 - 8) + 4 * hi;
#pragma unroll
        for (int jj = 0; jj < 4; ++jj) { const f32x2 cs = tp[jj]; const float x1 = f[2 * jj], x2 = f[2 * jj + 1]; f[2 * jj] = x1 * cs.x - x2 * cs.y; f[2 * jj + 1] = x1 * cs.y + x2 * cs.x; }
        qr[d0] = pack8(f); }
    CoreP P; P.K1 = mk_rsrc(A.ws, WS_BYTES); P.oK1 = OF_KVM + (unsigned)((b * SEQ * KVW + h * 256) * 2); P.K2 = P.K1; P.oK2 = OF_KPE + (unsigned)(b * SEQ * 64 * 2); P.V = P.K1; P.oV = P.oK1 + 256;
    P.NT = SEQ / 64; P.slope2 = 0.f; P.qrel0 = 0; P.R0 = 0; P.rlo = 0;
    f32x16 o[4]; float l_reg; float rli[16];
    attn_core_r<1, 128, 64, KVW, 64, KVW, (FA_PVP & 2) != 0>(qr, P, o, l_reg, lds);
    tid = fresh_tid(); lane = tid & 63; wid = __builtin_amdgcn_readfirstlane(tid >> 6); r32 = lane & 31; hi = lane >> 5;
    row0 = (long)b * SEQ + qb * 256 + wid * 32;
    row_inv(l_reg, rli, lds, wid, r32, hi);
    store_gated<NIN, DM>(o, rli, mk_rsrc(A.ws, WS_BYTES), OF_H1 + (unsigned)((row0 * NIN + E_GB + h * 128) * 2), OF_ATT + (unsigned)((row0 * DM + 1024 + h * 128) * 2), lds);
}
__device__ __forceinline__ void unit_gqa(const Ptrs& A, int b, int h, int qb, char* lds) {
    int tid = fresh_tid(), lane = tid & 63, wid = __builtin_amdgcn_readfirstlane(tid >> 6), r32 = lane & 31, hi = lane >> 5; long row0 = (long)b * SEQ + qb * 256 + wid * 32; const int tq = qb * 256 + wid * 32 + r32;
    bf16x8 qr[8];
    { float f[8][8]; const bf16* qp = A.H1 + (row0 + r32) * NIN + O_QD + h * 128 + hi * 8; float ss = 0.f;
#pragma unroll
      for (int d0 = 0; d0 < 8; ++d0) { unpack8(*(const bf16x8*)(qp + d0 * 16), f[d0]);
#pragma unroll
          for (int j = 0; j < 8; ++j) ss = fmaf(f[d0][j], f[d0][j], ss); }
      { auto rr = __builtin_amdgcn_permlane32_swap(__float_as_uint(ss), __float_as_uint(ss), false, false); ss = __uint_as_float(rr[0]) + __uint_as_float(rr[1]); }
      const float rstd = 1.0f / sqrtf(ss * (1.f / 128) + EPS);
#pragma unroll
      for (int d0 = 0; d0 < 8; ++d0)
#pragma unroll
          for (int j = 0; j < 8; ++j) f[d0][j] *= rstd * A.qnorm[d0 * 16 + hi * 8 + j];
      const float qs = 0.08838834764831845f * LOG2E;
#pragma unroll
      for (int half = 0; half < 2; ++half) { const int pos = half ? (tq & 63) : (tq >> 6);
#pragma unroll
          for (int dd = 0; dd < 2; ++dd) { const int d0 = 4 * half + dd; const f32x2* tp = A.TAB + pos * 32 + 16 * dd + 8 * hi;
#pragma unroll
              for (int j = 0; j < 8; ++j) { const f32x2 cs = tp[j]; const float x1 = f[d0][j], x2 = f[d0 + 2][j]; f[d0][j] = (x1 * cs.x - x2 * cs.y) * qs; f[d0 + 2][j] = (x1 * cs.y + x2 * cs.x) * qs; } } }
#pragma unroll
      for (int d0 = 0; d0 < 8; ++d0) qr[d0] = pack8(f[d0]); }
    const int kvh = h >> 2;
    CoreP P; P.K1 = mk_rsrc(A.ws, WS_BYTES); P.oK1 = OF_KG + (unsigned)((b * SEQ * 256 + kvh * 128) * 2); P.K2 = P.K1; P.oK2 = 0; P.V = P.K1; P.oV = OF_H1 + (unsigned)((b * SEQ * NIN + O_VD + kvh * 128) * 2);
    P.NT = SEQ / 64; P.slope2 = 0.f; P.qrel0 = 0; P.R0 = 0; P.rlo = 0;
    f32x16 o[4]; float l_reg; float rli[16];
    attn_core_r<2, 128, 0, 256, 8, NIN, (FA_PVP & 4) != 0>(qr, P, o, l_reg, lds);
    tid = fresh_tid(); lane = tid & 63; wid = __builtin_amdgcn_readfirstlane(tid >> 6); r32 = lane & 31; hi = lane >> 5;
    row0 = (long)b * SEQ + qb * 256 + wid * 32;
    row_inv(l_reg, rli, lds, wid, r32, hi);
    store_gated<NIN, DM>(o, rli, mk_rsrc(A.ws, WS_BYTES), OF_H1 + (unsigned)((row0 * NIN + O_GD + h * 128) * 2), OF_ATT + (unsigned)((row0 * DM + 1024 + h * 128) * 2), lds);
}
__device__ __forceinline__ void partialSM1(f32x16& p0, float& m_reg, float& alpha) {
    float pmax = p0[0];
#pragma unroll
    for (int r = 1; r < 16; ++r) pmax = fmaxf(pmax, p0[r]);
    { auto rr = __builtin_amdgcn_permlane32_swap(__float_as_uint(pmax), __float_as_uint(pmax), false, false); pmax = fmaxf(__uint_as_float(rr[0]), __uint_as_float(rr[1])); }
    float mn;
    if (__builtin_expect(__all(pmax - m_reg <= THR2), 1)) { mn = m_reg; alpha = 1.f; }
    else { mn = fmaxf(m_reg, pmax); alpha = __builtin_amdgcn_exp2f(m_reg - mn); m_reg = mn; }
#pragma unroll
    for (int r = 0; r < 16; ++r) p0[r] -= mn;
#pragma unroll
    for (int r = 0; r < 8; ++r) p0[r] = __builtin_amdgcn_exp2f(p0[r]);
}
__device__ __forceinline__ void finishSM1(f32x16& p0, float alpha, float& l_reg, bf16x8& pa0, bf16x8& pa1) {
#pragma unroll
    for (int r = 8; r < 16; ++r) p0[r] = __builtin_amdgcn_exp2f(p0[r]);
    float ps = 0;
#pragma unroll
    for (int r = 0; r < 16; ++r) ps += p0[r];
    { auto rr = __builtin_amdgcn_permlane32_swap(__float_as_uint(ps), __float_as_uint(ps), false, false); ps = __uint_as_float(rr[0]) + __uint_as_float(rr[1]); }
    l_reg = l_reg * alpha + ps;
#define FA_PK4(P, BASE, OUT) do { unsigned a0 = cvtpk(P[BASE + 0], P[BASE + 1]), a1 = cvtpk(P[BASE + 2], P[BASE + 3]);   \
    unsigned b0 = cvtpk(P[BASE + 4], P[BASE + 5]), b1 = cvtpk(P[BASE + 6], P[BASE + 7]);                              \
    auto r0 = __builtin_amdgcn_permlane32_swap(a0, b0, false, false); auto r1 = __builtin_amdgcn_permlane32_swap(a1, b1, false, false); \
    u32x4 w = {r0[0], r1[0], r0[1], r1[1]}; OUT = __builtin_bit_cast(bf16x8, w); } while (0)
    FA_PK4(p0, 0, pa0); FA_PK4(p0, 8, pa1);
#undef FA_PK4
}
template <int D0> __device__ __forceinline__ void pv_na_pair(f32x16* o, int vb, bf16x8 pa0, bf16x8 pa1) {
    const s16x4 l0 = tr_read<v_rd_off(D0, 0, 0)>(vb), h0 = tr_read<v_rd_off(D0, 0, 1)>(vb), l1 = tr_read<v_rd_off(D0, 1, 0)>(vb), h1 = tr_read<v_rd_off(D0, 1, 1)>(vb);
    const s16x4 l2 = tr_read<v_rd_off(D0 + 1, 0, 0)>(vb), h2 = tr_read<v_rd_off(D0 + 1, 0, 1)>(vb), l3 = tr_read<v_rd_off(D0 + 1, 1, 0)>(vb), h3 = tr_read<v_rd_off(D0 + 1, 1, 1)>(vb);
    asm volatile("s_waitcnt lgkmcnt(0)" ::: "memory"); FA_SBAR();
#define FA_PK(L, H) (bf16x8){L[0], L[1], L[2], L[3], H[0], H[1], H[2], H[3]}
    o[D0] = __builtin_amdgcn_mfma_f32_32x32x16_bf16(pa0, FA_PK(l0, h0), o[D0], 0, 0, 0);
    o[D0 + 1] = __builtin_amdgcn_mfma_f32_32x32x16_bf16(pa0, FA_PK(l2, h2), o[D0 + 1], 0, 0, 0);
    o[D0] = __builtin_amdgcn_mfma_f32_32x32x16_bf16(pa1, FA_PK(l1, h1), o[D0], 0, 0, 0);
    o[D0 + 1] = __builtin_amdgcn_mfma_f32_32x32x16_bf16(pa1, FA_PK(l3, h3), o[D0 + 1], 0, 0, 0);
#undef FA_PK
}
template <int LDK1, int LDV>
__device__ __forceinline__ void attn_core_na(const bf16x8* qr, const CoreP& P, f32x16 (&o)[4], float& l_reg, char* lds) {
    const int tid = fresh_tid(), lane = tid & 63, wid = __builtin_amdgcn_readfirstlane(tid >> 6), r32 = lane & 31, hi = lane >> 5;
    char* V_lds = lds + R_V; char* K1_lds = lds + R_K1;
    float* wsf = (float*)(lds + L_WS) + wid * 64; float* al_l = wsf + 32;
    float m_reg = -1e30f; l_reg = 0.f;
#pragma unroll
    for (int d = 0; d < 4; ++d) o[d] = f32x16{};
    const int sr = tid >> 4, sc = (tid & 15) * 8, vst0 = v_st(sr, sc), vst1 = v_st(32 + sr, sc);
    struct { bf16x8 vs0, vs1, ka0, ka1; } st;
    const unsigned voffV = (unsigned)((sr * LDV + sc) * 2), voffK1 = (unsigned)((sr * LDK1 + sc) * 2);
#define FR_SLOAD(k0) do { const unsigned vo_ = P.oV + (unsigned)(k0) * (LDV * 2); st.vs0 = bload16(P.V, voffV, vo_); st.vs1 = bload16(P.V, voffV, vo_ + 32 * LDV * 2); \
    const unsigned ko_ = P.oK1 + (unsigned)(k0) * (LDK1 * 2); st.ka0 = bload16(P.K1, voffK1, ko_); st.ka1 = bload16(P.K1, voffK1, ko_ + 32 * LDK1 * 2); } while (0)
#define FR_SWRITE(sl) do { *(bf16x8*)(V_lds + (sl) * SHM_V + vst0) = st.vs0; *(bf16x8*)(V_lds + (sl) * SHM_V + vst1) = st.vs1; \
    *(bf16x8*)(K1_lds + (sl) * SHM_K1 + FA_KSWZ(sr, sc * 2)) = st.ka0; *(bf16x8*)(K1_lds + (sl) * SHM_K1 + FA_KSWZ(32 + sr, sc * 2)) = st.ka1; } while (0)
#define FR_RESC(a) do { if (__any((a) < 1.f)) { if (hi == 0) al_l[r32] = (a); asm volatile("s_waitcnt lgkmcnt(0)" ::: "memory"); \
    _Pragma("unroll") for (int d = 0; d < 4; ++d) _Pragma("unroll") for (int r = 0; r < 16; ++r) o[d][r] *= al_l[crow(r, hi)]; } } while (0)
    const int cbk = wid & 3, m8 = cbk + (cbk >> 1), kb0 = 8 * m8;
    const int rq0 = P.R0 + 2 * (wid >> 2);
#define FR_QKT(P0, sl, t) do { P0 = f32x16{}; { const char* K1s = K1_lds + (sl) * SHM_K1; \
        _Pragma("unroll") for (int d0 = 0; d0 < 8; ++d0) { const int cb = (d0 * 16 + hi * 8) * 2; \
            const bf16x8 b0 = *reinterpret_cast<const bf16x8*>(K1s + FA_KSWZ(kb0 + r32, cb)); P0 = __builtin_amdgcn_mfma_f32_32x32x16_bf16(b0, qr[d0], P0, 0, 0, 0); } } \
    { const int kr = P.rlo + (t); int l3 = lane; asm volatile("" : "+v"(l3)); \
      const int hi3 = l3 >> 5, rq3 = rq0 + ((l3 >> 4) & 1), cq3 = cbk * 16 + (l3 & 15), c03 = min(max(cq3 - 8, 0), 48), rl3 = min(max(rq3 - 4, 0), 56); \
      const bool rowok = (unsigned)(kr - rl3) < 8u; const int dr = min(max(kr - rq3 + 7, 0), 14); \
      const float* rp = (const float*)(lds + L_RPB) + 64 + dr * 32 - cq3 + 15 + kb0 + 4 * hi3; const int tb = kb0 + 4 * hi3 - c03; \
      _Pragma("unroll") for (int r = 0; r < 16; ++r) { const int cr = (r & 3) + 8 * (r >> 2); \
          P0[r] = (rowok && (unsigned)(tb + cr) < 16u) ? P0[r] + rp[cr] : -INFINITY; } } \
    } while (0)
    f32x16 pA, pB; float alA = 1.f, alB = 1.f; bf16x8 pa0, pa1; const int NT = P.NT;
    int s_prev = 0, s_cur = 1, s_next = 2;
#define FR_HALF(t, X, ALX, Y, ALY) do { \
    FA_SBAR(); FR_QKT(X, s_cur, t); \
    finishSM1(Y, ALY, l_reg, pa0, pa1); FA_SBAR(); \
    if ((t) + 1 < NT) { FR_SWRITE(s_next); if ((t) + 2 < NT) FR_SLOAD(((t) + 2) * 64); } FA_SBAR(); \
    { const int vb_ = vb0 + s_prev * SHM_V; pv_na_pair<0>(o, vb_, pa0, pa1); pv_na_pair<2>(o, vb_, pa0, pa1); } \
    partialSM1(X, m_reg, ALX); FR_RESC(ALX); \
    __syncthreads(); { const int s_ = s_prev; s_prev = s_cur; s_cur = s_next; s_next = s_; } } while (0)
#define FR_VB() ((int)(uintptr_t)V_lds + v_rd_base(fresh_tid() & 63) - ((fresh_tid() >> 5) & 1) * 256 + (((((fresh_tid() >> 5) & 1) + m8) >> 1) * 4096) + (((((fresh_tid() >> 5) & 1) + m8) & 1) * 256))
#define FR_TAIL(Y, ALY) do { finishSM1(Y, ALY, l_reg, pa0, pa1); FA_SBAR(); const int vb1 = FR_VB() + s_prev * SHM_V; pv_na_pair<0>(o, vb1, pa0, pa1); pv_na_pair<2>(o, vb1, pa0, pa1); } while (0)
    FR_SLOAD(0); FR_SWRITE(0);
    if (NT > 1) { FR_SLOAD(64); FR_SWRITE(1); }
    __syncthreads();
    FR_QKT(pA, 0, 0); partialSM1(pA, m_reg, alA);
    if (NT > 2) FR_SLOAD(128);
    const int vb0 = FR_VB();
    int t = 1;
#pragma clang loop unroll(disable)
    for (; t + 1 < NT; t += 2) { FR_HALF(t, pB, alB, pA, alA); FR_HALF(t + 1, pA, alA, pB, alB); }
    if (t < NT) { FR_HALF(t, pB, alB, pA, alA); FR_TAIL(pB, alB); }
    else { FR_TAIL(pA, alA); }
    asm volatile("s_waitcnt vmcnt(0) lgkmcnt(0)" ::: "memory"); __syncthreads();
#undef FR_SLOAD
#undef FR_SWRITE
#undef FR_RESC
#undef FR_QKT
#undef FR_HALF
#undef FR_TAIL
#undef FR_VB
}
__device__ __forceinline__ void unit_na(const Ptrs& A, int b, int h, int qb, char* lds) {
    int tid = fresh_tid(), lane = tid & 63, wid = __builtin_amdgcn_readfirstlane(tid >> 6), r32 = lane & 31, hi = lane >> 5;
    const int R0 = qb * 4;
    long tok0 = (long)b * SEQ + (R0 + 2 * (wid >> 2)) * 64 + 16 * (wid & 3);
    { float* rp = (float*)(lds + L_RPB);
      for (int i = tid; i < 640; i += 512) { const int e = i - 64; float v = 0.f; if (e >= 0 && e < 480 && (e & 31) < 31) v = A.rpb[h * 465 + (e >> 5) * 31 + (e & 31)] * LOG2E; rp[i] = v; } }
    bf16x8 qr[8]; const bf16* qp = A.H1 + (tok0 + (r32 >> 4) * 64 + (r32 & 15)) * NIN + O_QC + h * 128 + hi * 8;
#pragma unroll
    for (int d0 = 0; d0 < 8; ++d0) qr[d0] = *(const bf16x8*)(qp + d0 * 16);
    const int rlo = min(max(R0 - 4, 0), 56), nt_na = min(max(R0 - 1, 0), 56) + 8 - rlo;
    CoreP P; P.K1 = mk_rsrc(A.ws, WS_BYTES); P.oK1 = OF_H1 + (unsigned)(((b * SEQ + rlo * 64) * NIN + O_KC + h * 128) * 2); P.K2 = P.K1; P.oK2 = 0; P.V = P.K1; P.oV = OF_H1 + (unsigned)(((b * SEQ + rlo * 64) * NIN + O_VC + h * 128) * 2);
    P.NT = nt_na; P.slope2 = 0.f; P.qrel0 = 0; P.R0 = R0; P.rlo = rlo;
    f32x16 o[4]; float l_reg; float rli[16];
    attn_core_na<NIN, NIN>(qr, P, o, l_reg, lds);
    tid = fresh_tid(); lane = tid & 63; wid = __builtin_amdgcn_readfirstlane(tid >> 6); r32 = lane & 31; hi = lane >> 5;
    tok0 = (long)b * SEQ + (R0 + 2 * (wid >> 2)) * 64 + 16 * (wid & 3);
    row_inv(l_reg, rli, lds, wid, r32, hi);
    store_gated<NIN, DM, true>(o, rli, mk_rsrc(A.ws, WS_BYTES), OF_H1 + (unsigned)((tok0 * NIN + O_GC + h * 128) * 2), OF_ATT + (unsigned)((tok0 * DM + h * 128) * 2), lds);
}
}


struct Frame {
    LAS unsigned char* lds;
    volatile LAS unsigned* MISC;
    gu32* ctl;
    int vcu, G;
};
struct Args { const float* in[19]; float* out; unsigned char* ws; int ph_lo, ph_hi; };

struct MapIn0 {
    __device__ __forceinline__ void operator()(int n, int& sc, float& cs) const {
        cs = 1.f;
        if (n < E_GB) { sc = n; if (n < 1024) cs = 0.125f * LOG2E; }
        else if (n < E_KR) sc = 5440 + (n - E_GB);
        else if (n < E_KR + 64) { const int j = n - E_KR; sc = 5376 + (j >> 1) + 32 * (j & 1); }
        else sc = -1;
    }
};
struct MapUq {
    __device__ __forceinline__ void operator()(int n, int& sc, float& cs) const {
        cs = 0.07216878364870322f * LOG2E;
        const int h = n / 192, r = n % 192;
        if (r < 128) sc = n; else { const int j = r - 128; sc = h * 192 + 128 + (j >> 1) + 32 * (j & 1); }
    }
};
struct MapId {
    int nsc; float cs0;
    __device__ __forceinline__ void operator()(int n, int& sc, float& cs) const { sc = n; cs = (n < nsc) ? cs0 : 1.f; }
};
template <class Map>
__device__ __forceinline__ void p0_transpose_item(const float* W, int K, int Nsrc, bf16* WT, int nblk, LAS float* scr, int item, int lane, const Map& mp, const float* kscale) {
    const int kb = item / nblk, nb = item % nblk, k0 = 64 * kb, n0 = 32 * nb;
    int sc; float cs; mp(n0 + (lane & 31), sc, cs);
    float wv[32];
    const float* wp = W + (size_t)(k0 + (lane >> 5)) * Nsrc + (sc >= 0 ? sc : 0);
#pragma unroll
    for (int i = 0; i < 32; ++i) wv[i] = wp[(size_t)(2 * i) * Nsrc];
#pragma unroll
    for (int i = 0; i < 32; ++i) { const int kk = 2 * i + (lane >> 5); float w = (sc >= 0) ? wv[i] * cs : 0.f; if (kscale) w *= kscale[k0 + kk]; scr[kk * 33 + (lane & 31)] = w; }
    LDS_WAIT(); asm volatile("" ::: "memory");
    const int c = lane & 7;
#pragma unroll
    for (int j = 0; j < 4; ++j) { const int n = (lane >> 3) + 8 * j; const LAS float* s = scr + (8 * c) * 33 + n;
        v4u o; o.x = pk2(s[0 * 33], s[1 * 33]); o.y = pk2(s[2 * 33], s[3 * 33]); o.z = pk2(s[4 * 33], s[5 * 33]); o.w = pk2(s[6 * 33], s[7 * 33]);
        *(GAS v4u*)(WT + (size_t)(n0 + n) * K + k0 + 8 * c) = o; }
    LDS_WAIT(); asm volatile("" ::: "memory");
}
template <class Map>
__device__ __forceinline__ void p0_transpose(Frame& F, int wave, int lane, const float* W, int K, int Nsrc, int Ndst, bf16* WT, const Map& mp, const float* kscale) {
    LAS float* scr = (LAS float*)(F.lds + RING_OFF + wave * 16384);
    const int gw = F.vcu * NWAVES + wave, NGW = F.G * NWAVES, nblk = Ndst / 32, nitems = (K / 64) * nblk;
    for (int it = gw; it < nitems; it += NGW) p0_transpose_item(W, K, Nsrc, WT, nblk, scr, it, lane, mp, kscale);
}
__device__ __forceinline__ void xn_row(const float* xrow, const float* gain, bf16* orow, int lane) {
    const GAS f32x4* xr = (const GAS f32x4*)xrow + lane; const GAS f32x4* gr = (const GAS f32x4*)gain + lane;
    f32x4 v[8]; float s = 0.f;
#pragma unroll
    for (int j = 0; j < 8; ++j) { v[j] = xr[64 * j]; s += (v[j].x * v[j].x + v[j].y * v[j].y) + (v[j].z * v[j].z + v[j].w * v[j].w); }
    const float rstd = 1.0f / sqrtf(wave_sum(s) * (1.f / DM) + EPS);
    GAS v2u* o8 = (GAS v2u*)orow + lane;
#pragma unroll
    for (int j = 0; j < 8; ++j) { const f32x4 g = gr[64 * j]; v2u o; o.x = pk2(v[j].x * rstd * g.x, v[j].y * rstd * g.y); o.y = pk2(v[j].z * rstd * g.z, v[j].w * rstd * g.w); o8[64 * j] = o; }
}
__device__ __forceinline__ void tab_entry(int pos, int i, float& c, float& s) {
    double inv = 1.0; for (int k = 0; k < i; ++k) inv *= 0.7498942093324559;
    const double ang = (double)pos * inv;
    const double kq = rint(ang * 0.6366197723675814);
    const double rr = (ang - kq * 1.5707963267948966) - kq * 6.123233995736766e-17;
    const int q = ((int)kq) & 3;
    const double r2 = rr * rr;
    const double sn = rr * (1.0 + r2 * (-1.0 / 6 + r2 * (1.0 / 120 + r2 * (-1.0 / 5040 + r2 * (1.0 / 362880 + r2 * (-1.0 / 39916800 + r2 * (1.0 / 6227020800.0)))))));
    const double cs = 1.0 + r2 * (-0.5 + r2 * (1.0 / 24 + r2 * (-1.0 / 720 + r2 * (1.0 / 40320 + r2 * (-1.0 / 3628800 + r2 * (1.0 / 479001600.0 + r2 * (-1.0 / 87178291200.0)))))));
    double cc, ss;
    if (q == 0) { cc = cs; ss = sn; } else if (q == 1) { cc = -sn; ss = cs; } else if (q == 2) { cc = -cs; ss = -sn; } else { cc = sn; ss = -cs; }
    c = (float)cc; s = (float)ss;
}

template <int NR> __device__ __forceinline__ void xn_rows(const float* x, const float* gain, bf16* XN, int m0, int mstep, int lane) {
    f32x4 v[NR][8]; float s[NR];
#pragma unroll
    for (int r = 0; r < NR; ++r) { const GAS f32x4* xr = (const GAS f32x4*)(x + (size_t)(m0 + r * mstep) * DM) + lane; s[r] = 0.f;
#pragma unroll
        for (int j = 0; j < 8; ++j) v[r][j] = __builtin_nontemporal_load(xr + 64 * j); }
    const GAS f32x4* gr = (const GAS f32x4*)gain + lane;
#pragma unroll
    for (int r = 0; r < NR; ++r) {
#pragma unroll
        for (int j = 0; j < 8; ++j) s[r] += (v[r][j].x * v[r][j].x + v[r][j].y * v[r][j].y) + (v[r][j].z * v[r][j].z + v[r][j].w * v[r][j].w);
        const float rstd = 1.0f / sqrtf(wave_sum(s[r]) * (1.f / DM) + EPS);
        GAS v2u* o8 = (GAS v2u*)(XN + (size_t)(m0 + r * mstep) * DM) + lane;
#pragma unroll
        for (int j = 0; j < 8; ++j) { const f32x4 g = gr[64 * j]; v2u o; o.x = pk2(v[r][j].x * rstd * g.x, v[r][j].y * rstd * g.y); o.y = pk2(v[r][j].z * rstd * g.z, v[r][j].w * rstd * g.w); o8[64 * j] = o; } }
}
template <int NR, bool WITH_XN, bool XIN_B = false, bool XOUT_B = false> __device__ __forceinline__ void resid_rows(const void* xin_, const bf16* MB, const float* RSS, const float* gpost, const float* gpre, void* xout_, bf16* XN, int m0, int mstep, int lane) {
    f32x4 v[NR][8]; v2u mw[NR][8]; float ssm[NR];
#pragma unroll
    for (int r = 0; r < NR; ++r) { const int m = m0 + r * mstep; const GAS v2u* mr = (const GAS v2u*)(MB + (size_t)m * DM) + lane;
        ssm[r] = lane < 32 ? RSS[(size_t)m * 32 + lane] : 0.f;
        if constexpr (XIN_B) { const GAS v2u* xr = (const GAS v2u*)((const bf16*)xin_ + (size_t)m * DM) + lane;
#pragma unroll
            for (int j = 0; j < 8; ++j) { const v2u w = __builtin_nontemporal_load(xr + 64 * j); v[r][j] = (f32x4){bflo(w.x), bfhi(w.x), bflo(w.y), bfhi(w.y)}; mw[r][j] = __builtin_nontemporal_load(mr + 64 * j); } }
        else { const GAS f32x4* xr = (const GAS f32x4*)((const float*)xin_ + (size_t)m * DM) + lane;
#pragma unroll
            for (int j = 0; j < 8; ++j) { v[r][j] = __builtin_nontemporal_load(xr + 64 * j); mw[r][j] = __builtin_nontemporal_load(mr + 64 * j); } } }
    const GAS f32x4* g2 = (const GAS f32x4*)gpost + lane; const GAS f32x4* g1 = (const GAS f32x4*)gpre + lane;
#pragma unroll
    for (int r = 0; r < NR; ++r) { const int m = m0 + r * mstep; const float rm = 1.0f / sqrtf(wave_sum(ssm[r]) * (1.f / DM) + EPS);
        GAS f32x4* orow = (GAS f32x4*)((float*)xout_ + (size_t)m * DM) + lane; GAS v2u* orowb = (GAS v2u*)((bf16*)xout_ + (size_t)m * DM) + lane; float s = 0.f;
#pragma unroll
        for (int j = 0; j < 8; ++j) { const f32x4 xv = v[r][j], g = g2[64 * j]; const v2u w = mw[r][j];
            f32x4 t; t.x = xv.x + bflo(w.x) * rm * g.x; t.y = xv.y + bfhi(w.x) * rm * g.y; t.z = xv.z + bflo(w.y) * rm * g.z; t.w = xv.w + bfhi(w.y) * rm * g.w;
            v[r][j] = t; if constexpr (XOUT_B) { v2u ob; ob.x = pk2(t.x, t.y); ob.y = pk2(t.z, t.w); __builtin_nontemporal_store(ob, orowb + 64 * j); } else __builtin_nontemporal_store(t, orow + 64 * j);
            s += (t.x * t.x + t.y * t.y) + (t.z * t.z + t.w * t.w); }
        if constexpr (WITH_XN) { const float rstd = 1.0f / sqrtf(wave_sum(s) * (1.f / DM) + EPS); GAS v2u* o8 = (GAS v2u*)(XN + (size_t)m * DM) + lane;
#pragma unroll
            for (int j = 0; j < 8; ++j) { const f32x4 g = g1[64 * j]; v2u o; o.x = pk2(v[r][j].x * rstd * g.x, v[r][j].y * rstd * g.y); o.y = pk2(v[r][j].z * rstd * g.z, v[r][j].w * rstd * g.w); o8[64 * j] = o; } } }
}

__global__ void __launch_bounds__(NWAVES * 64, 2) mega(Args args) {
    extern __shared__ __attribute__((aligned(16))) unsigned char lds[];
    Frame F;
    F.lds = (LAS unsigned char*)lds;
    F.MISC = (volatile LAS unsigned*)(F.lds + MISC_OFF);
    F.G = gridDim.x; { const int bx = blockIdx.x; F.vcu = (F.G % 8 == 0) ? (bx % 8) * (F.G / 8) + bx / 8 : bx; }
    unsigned char* ws = args.ws;
    F.ctl = (gu32*)(ws + WS_CTL);
    for (int u = threadIdx.x; u < (LDS_BYTES - LDSCTL_OFF) / 4; u += NWAVES * 64) ((LAS unsigned*)(F.lds + LDSCTL_OFF))[u] = 0u;
    __syncthreads();
    const int lo = args.ph_lo, hi = args.ph_hi;
    const bool use_bar = (hi - lo) > 1;
    XcdBarrier bar; bar.bar = (unsigned*)(F.ctl + CW_BAR); bar.x = 0; bar.st = nullptr;
    if (use_bar) bar = xcd_barrier_post((unsigned*)(F.ctl + CW_BAR), F.MISC + 8);
#define IN(k) (lo <= (k) && (k) < hi)
#define SEAM(k) do { if (IN(k) && IN((k) + 1)) xcd_barrier(bar); } while (0)
    const float* x = args.in[0];
    bf16* WIN0 = (bf16*)(ws + WS_WIN0); bf16* WOUT0 = (bf16*)(ws + WS_WOUT0); bf16* WUQ = (bf16*)(ws + WS_WUQ); bf16* WUKV = (bf16*)(ws + WS_WUKV);
    bf16* WIN1 = (bf16*)(ws + WS_WIN1); bf16* WOUT1 = (bf16*)(ws + WS_WOUT1);
    bf16* XN = (bf16*)(ws + WS_XN); bf16* KVM = (bf16*)(ws + WS_KVM); bf16* H1 = (bf16*)(ws + WS_H1); bf16* MB = (bf16*)(ws + WS_MB); bf16* QM = (bf16*)(ws + WS_QM);
    bf16* X1B = (bf16*)(ws + WS_X1B); bf16* ATT = (bf16*)(ws + WS_ATT); bf16* KPE = (bf16*)(ws + WS_KPE); bf16* KG = (bf16*)(ws + WS_KG);
    unsigned* KMAX = (unsigned*)(ws + WS_CTL) + CW_KMAX; float* RSS = (float*)(ws + WS_RSS); float* SSQ = (float*)(ws + WS_SSQ); float* CONSTS = (float*)(ws + WS_CONST); f32x2* TAB = (f32x2*)(ws + WS_TAB);
    const int NGW = F.G * NWAVES, NGT = NGW * 64;
#define PHASE_IDS() const int tid = fresh_tid(), lane = tid & 63, wave = __builtin_amdgcn_readfirstlane(tid >> 6), gw = F.vcu * NWAVES + wave, gt = gw * 64 + lane; (void)gt; (void)gw; (void)lane; (void)wave

    if (IN(0)) {
        asm volatile(".rept " PAD_STR(PAD_P0) "\n\ts_nop 0\n\t.endr" ::: "memory");
        PHASE_IDS();
        { LAS float* scr = (LAS float*)(F.lds + RING_OFF + wave * 16384);
          constexpr int I_IN = (DM / 64) * (NIN / 32), I_OUT = (DM / 64) * (DM / 32), I_UQ = (768 / 64) * (1536 / 32), I_UKV = (512 / 64) * (2048 / 32), I_ALL = I_IN + I_OUT + I_UQ + I_UKV;
          for (int it = gw; it < I_ALL; it += NGW) { int r = it;
              if (r < I_IN) { p0_transpose_item(args.in[3], DM, 6464, WIN0, NIN / 32, scr, r, lane, MapIn0{}, nullptr); continue; } r -= I_IN;
              if (r < I_OUT) { p0_transpose_item(args.in[4], DM, DM, WOUT0, DM / 32, scr, r, lane, MapId{0, 1.f}, nullptr); continue; } r -= I_OUT;
              if (r < I_UQ) { p0_transpose_item(args.in[11], 768, 1536, WUQ, 1536 / 32, scr, r, lane, MapUq{}, args.in[10]); continue; } r -= I_UQ;
              p0_transpose_item(args.in[13], 512, 2048, WUKV, 2048 / 32, scr, r, lane, MapId{0, 1.f}, args.in[12]); } }
        { int mm = gw; for (; mm + NGW < MTOK; mm += 2 * NGW) xn_rows<2>(x, args.in[1], XN, mm, NGW, lane); if (mm < MTOK) xn_rows<1>(x, args.in[1], XN, mm, NGW, lane); }
        for (int e = gt; e < 4096 * 32; e += NGT) { float c, s; tab_entry(e >> 5, e & 31, c, s); TAB[e] = (f32x2){c, s}; }
        if (gw == 0) { const float a1 = wave_sum(args.in[5][lane] * args.in[6][lane]), a2 = wave_sum(args.in[7][lane] * args.in[8][lane]); if (lane == 0) CONSTS[0] = expf(a1) - expf(a2) + 0.2f; }
    }
    SEAM(0);
    if (IN(1)) {
        pg8::Gemm g{XN, WIN0, MTOK, NIN, DM, DM}; pg8::StaticOrder S; S.init(MTOK, NIN, F.G, (int)blockIdx.x);
        pg8::EpiOut E{H1, NIN, nullptr, 0, 0, 0.f, 0.f, SSQ, SSLD, E_CQ / 256, E_GB / 256, nullptr};
        pg8::gemm_phase<pg8::EpiOut, pg8::StaticOrder, GEMM_ALIGN, GEMM_SP2>(F.lds + RING_OFF, g, S, E);
        { const int nun = (MTOK / 256) * (NIN / 256), rem = nun % F.G, nlight = (rem == 0) ? F.G : F.G - rem, lid = (rem == 0) ? (int)blockIdx.x : (int)blockIdx.x - rem;
          if (lid >= 0) { PHASE_IDS(); LAS float* scr = (LAS float*)(F.lds + RING_OFF + wave * 16384);
              constexpr int I_IN = (DM / 64) * (NIN / 32), I_OUT = (DM / 64) * (DM / 32);
              for (int it = lid * NWAVES + wave; it < I_IN + I_OUT; it += nlight * NWAVES) {
                  if (it < I_IN) p0_transpose_item(args.in[14], DM, 6656, WIN1, NIN / 32, scr, it, lane, MapId{1024, 0.08838834764831845f * LOG2E}, nullptr);
                  else p0_transpose_item(args.in[15], DM, DM, WOUT1, DM / 32, scr, it - I_IN, lane, MapId{0, 1.f}, nullptr); } } }
    }
    SEAM(1);
    if (IN(2)) {
        PHASE_IDS();
        for (int e = gt; e < MTOK * 32; e += NGT) { const int tok = e >> 5, i = e & 31; const unsigned w = *(const unsigned*)(H1 + (size_t)tok * NIN + E_KR + 2 * i);
            const f32x2 cs = TAB[(tok % SEQ) * 32 + i]; const float x1 = bflo(w), x2 = bfhi(w); *(unsigned*)(KPE + (size_t)tok * 64 + 2 * i) = pk2(x1 * cs.x - x2 * cs.y, x1 * cs.y + x2 * cs.x); }
        { float mx = 0.f; int curb = -1;
          for (int m0 = gw; m0 < MTOK; m0 += 4 * NGW) { v4u w0[4], w1[4];
#pragma unroll
              for (int u = 0; u < 4; ++u) { const int mt = m0 + u * NGW; if (mt < MTOK) { const bf16* kp = H1 + (size_t)mt * NIN + E_KA + 16 * lane; w0[u] = *(const v4u*)kp; w1[u] = *(const v4u*)(kp + 8); } else { w0[u] = (v4u){0u, 0u, 0u, 0u}; w1[u] = w0[u]; } }
#pragma unroll
              for (int u = 0; u < 4; ++u) { const int mt = m0 + u * NGW; if (mt < MTOK) { const int b = mt / SEQ;
                  if (b != curb) { if (curb >= 0 && (lane & 3) == 0) atomicMax(KMAX + fa::KM_DIFF + curb * 16 + (lane >> 2), __float_as_uint(mx)); mx = 0.f; curb = b; }
                  float ss = 0.f;
#pragma unroll
                  for (int e = 0; e < 4; ++e) { ss += bflo(w0[u][e]) * bflo(w0[u][e]) + bfhi(w0[u][e]) * bfhi(w0[u][e]); ss += bflo(w1[u][e]) * bflo(w1[u][e]) + bfhi(w1[u][e]) * bfhi(w1[u][e]); }
                  ss += __shfl_xor(ss, 1); ss += __shfl_xor(ss, 2); mx = fmaxf(mx, ss); } } }
          if (curb >= 0 && (lane & 3) == 0) atomicMax(KMAX + fa::KM_DIFF + curb * 16 + (lane >> 2), __float_as_uint(mx)); }
        { pg8::Gemm g{H1 + E_CQ, WUQ, MTOK, QMW, 768, NIN}; pg8::StaticOrder S; S.init(MTOK, QMW, F.G, (int)blockIdx.x);
          pg8::EpiOut E{QM, QMW, SSQ, SSLD, 12, 1.f / 768, EPS, nullptr, 0, 0, 0, nullptr};
          pg8::gemm_phase<pg8::EpiOut, pg8::StaticOrder, GEMM_ALIGN, GEMM_SP2>(F.lds + RING_OFF, g, S, E); }
        { pg8::Gemm g{H1 + E_CKV, WUKV, MTOK, KVW, 512, NIN}; pg8::SplitOrder S; S.init(MTOK, KVW, F.G, (int)blockIdx.x); S.nlo = F.G / 2; S.lo = 1; S.hi = 3;
          pg8::EpiOut E{KVM, KVW, SSQ + 12, SSLD, 8, 1.f / 512, EPS, nullptr, 0, 0, 0, nullptr};
          if (F.G == 256) pg8::gemm_phase<pg8::EpiOut, pg8::SplitOrder, GEMM_ALIGN, GEMM_SP2>(F.lds + RING_OFF, g, S, E);
          else { pg8::StaticOrder S0; S0.init(MTOK, KVW, F.G, (int)(F.G - 1 - blockIdx.x)); pg8::gemm_phase<pg8::EpiOut, pg8::StaticOrder, GEMM_ALIGN, GEMM_SP2>(F.lds + RING_OFF, g, S0, E); } }
    }
    SEAM(2);
    if (IN(3)) {
        asm volatile(".rept " PAD_STR(PAD_P3) "\n\ts_nop 0\n\t.endr" ::: "memory");
        PHASE_IDS();
        const fa::Ptrs A{H1, QM, KVM, KPE, KG, ATT, TAB, CONSTS, args.in[9], args.in[17], args.in[16], args.out, KMAX, ws};
        unsigned* QC = (unsigned*)(ws + WS_CTL) + CW_QCTR; volatile LAS unsigned* qslot = F.MISC + 16;
        const int q0 = (F.vcu * 8) / F.G;
        for (int qq = 0; qq < 8; ++qq) { const int queue = (q0 + qq) & 7;
            for (;;) {
                int z = 0; asm volatile("" : "+v"(z));
                if (tid == 0) qslot[z] = atomicAdd(QC + 64 * queue, 1u);
                __syncthreads();
                const int idx = __builtin_amdgcn_readfirstlane((int)qslot[z]);
                __syncthreads();
                if (idx >= 128) break;
                int type, h, qbl;
                if (idx < 24) { type = 0; h = 7 - (idx >> 3); qbl = idx & 7; } else if (idx < 88) { type = 1; h = (idx - 24) >> 3; qbl = (idx - 24) & 7; } else { type = 0; h = 4 - ((idx - 88) >> 3); qbl = (idx - 88) & 7; }
                const int b = queue >> 1, qb = (queue & 1) ? 8 + qbl : 7 - qbl;
                if (type == 0) fa::unit_diff(A, b, h, qb, (char*)lds + RING_OFF);
                else fa::unit_mla(A, b, h, qb, (char*)lds + RING_OFF);
            } }
    }
    SEAM(3);
    if (IN(4)) {
        asm volatile(".rept " PAD_STR(PAD_P4) "\n\ts_nop 0\n\t.endr" ::: "memory");
        pg8::Gemm g{ATT, WOUT0, MTOK, DM, DM, DM}; pg8::StaticOrder S; S.init(MTOK, DM, F.G, (int)blockIdx.x);
        pg8::EpiOut E{MB, DM, nullptr, 0, 0, 0.f, 0.f, RSS, 32, 0, 8, nullptr};
        pg8::gemm_phase<pg8::EpiOut, pg8::StaticOrder, GEMM_ALIGN, GEMM_SP2>(F.lds + RING_OFF, g, S, E);
    }
    SEAM(4);
    if (IN(5)) {
        PHASE_IDS();
        { int mm = gw; for (; mm + NGW < MTOK; mm += 2 * NGW) resid_rows<2, true, false, true>(x, MB, RSS, args.in[2], args.in[1] + DM, X1B, XN, mm, NGW, lane);
          if (mm < MTOK) resid_rows<1, true, false, true>(x, MB, RSS, args.in[2], args.in[1] + DM, X1B, XN, mm, NGW, lane); }
    }
    SEAM(5);
    if (IN(6)) {
        pg8::Gemm g{XN, WIN1, MTOK, NIN, DM, DM}; pg8::StaticOrder S; S.init(MTOK, NIN, F.G, (int)blockIdx.x);
        pg8::EpiOut E{H1, NIN, nullptr, 0, 0, 0.f, 0.f, nullptr, 0, 0, 0, nullptr};
        pg8::gemm_phase<pg8::EpiOut, pg8::StaticOrder, GEMM_ALIGN, GEMM_SP2>(F.lds + RING_OFF, g, S, E);
    }
    SEAM(6);
    if (IN(7)) {
        asm volatile(".rept " PAD_STR(PAD_P7) "\n\ts_nop 0\n\t.endr" ::: "memory");
        PHASE_IDS();
        const int hh = lane >> 5, i = lane & 31; const float* kn = args.in[18];
        const float g0 = kn[i], g1 = kn[i + 32], g2 = kn[i + 64], g3 = kn[i + 96];
        for (int m0 = gw; m0 < MTOK; m0 += 4 * NGW) {
            float a[4][4]; f32x2 c1[4], c2[4];
#pragma unroll
            for (int u = 0; u < 4; ++u) { const int m = min(m0 + u * NGW, MTOK - 1); const bf16* kp = H1 + (size_t)m * NIN + O_KD + hh * 128;
                a[u][0] = bf1(kp[i]); a[u][1] = bf1(kp[i + 32]); a[u][2] = bf1(kp[i + 64]); a[u][3] = bf1(kp[i + 96]);
                const int t = m % SEQ; c1[u] = TAB[(t >> 6) * 32 + i]; c2[u] = TAB[(t & 63) * 32 + i]; }
#pragma unroll
            for (int u = 0; u < 4; ++u) { const int m = m0 + u * NGW; if (m < MTOK) {
                float ss = (a[u][0] * a[u][0] + a[u][1] * a[u][1]) + (a[u][2] * a[u][2] + a[u][3] * a[u][3]);
#pragma unroll
                for (int o = 1; o < 32; o <<= 1) ss += __shfl_xor(ss, o);
                const float rstd = 1.0f / sqrtf(ss * (1.f / 128) + EPS);
                const float x1 = a[u][0] * rstd * g0, x2 = a[u][1] * rstd * g1, y1 = a[u][2] * rstd * g2, y2 = a[u][3] * rstd * g3;
                bf16* op = KG + (size_t)m * 256 + hh * 128;
                op[i] = (bf16)f2bf(x1 * c1[u].x - x2 * c1[u].y); op[i + 32] = (bf16)f2bf(x1 * c1[u].y + x2 * c1[u].x); op[i + 64] = (bf16)f2bf(y1 * c2[u].x - y2 * c2[u].y); op[i + 96] = (bf16)f2bf(y1 * c2[u].y + y2 * c2[u].x); } }
        }
    }
    SEAM(7);
    if (IN(8)) {
        PHASE_IDS();
        const fa::Ptrs A{H1, QM, KVM, KPE, KG, ATT, TAB, CONSTS, args.in[9], args.in[17], args.in[16], args.out, KMAX, ws};
        for (int i = 0;; ++i) { const int u = i * F.G + F.vcu; if (u >= 1024) break; const int type = u >> 9, idx = u & 511, bh = idx >> 4, qb = idx & 15;
            if (type == 0) fa::unit_na(A, bh >> 3, bh & 7, qb, (char*)lds + RING_OFF);
            else fa::unit_gqa(A, bh >> 3, bh & 7, qb, (char*)lds + RING_OFF); }
    }
    SEAM(8);
    if (IN(9)) {
        pg8::Gemm g{ATT, WOUT1, MTOK, DM, DM, DM}; pg8::StaticOrder S; S.init(MTOK, DM, F.G, (int)blockIdx.x);
        pg8::EpiOut E{MB, DM, nullptr, 0, 0, 0.f, 0.f, RSS, 32, 0, 8, nullptr};
        pg8::gemm_phase<pg8::EpiOut, pg8::StaticOrder, GEMM_ALIGN, GEMM_SP2>(F.lds + RING_OFF, g, S, E);
    }
    SEAM(9);
    if (IN(10)) {
        PHASE_IDS();
        { int mm = gw; for (; mm + NGW < MTOK; mm += 2 * NGW) resid_rows<2, false, true, false>(X1B, MB, RSS, args.in[2] + DM, nullptr, args.out, nullptr, mm, NGW, lane);
          if (mm < MTOK) resid_rows<1, false, true, false>(X1B, MB, RSS, args.in[2] + DM, nullptr, args.out, nullptr, mm, NGW, lane); }
    }
#undef IN
#undef SEAM
#undef PHASE_IDS
}

extern "C" void kernel_launch(void* const* d_in, const int* in_sizes, int n_in, void* d_out, int out_size, void* d_ws, size_t ws_size, hipStream_t stream) {
    static int grid = 0;
    if (grid == 0) {
        if (n_in != 19 || in_sizes[0] != MTOK * DM || out_size != MTOK * DM || ws_size < WS_END) {
            fprintf(stderr, "kernel_launch: unexpected shapes: n_in %d in0 %d out %d ws %zu (need >= %zu)\n", n_in, n_in > 0 ? in_sizes[0] : -1, out_size, ws_size, (size_t)WS_END); grid = -1; return; }
        int dev = 0, cus = 0, per_cu = 0;
        if (hipGetDevice(&dev) != hipSuccess || hipDeviceGetAttribute(&cus, hipDeviceAttributeMultiprocessorCount, dev) != hipSuccess) { grid = -1; return; }
        if (hipFuncSetAttribute((const void*)mega, hipFuncAttributeMaxDynamicSharedMemorySize, LDS_BYTES) != hipSuccess) { fprintf(stderr, "kernel_launch: hipFuncSetAttribute failed\n"); grid = -1; return; }
        if (hipOccupancyMaxActiveBlocksPerMultiprocessor(&per_cu, (const void*)mega, NWAVES * 64, LDS_BYTES) != hipSuccess || per_cu < 1) { fprintf(stderr, "kernel_launch: occupancy query failed (%d)\n", per_cu); per_cu = 1; }
        (void)hipGetLastError();
        grid = cus * per_cu;
    }
    if (grid < 0) return;
    (void)hipMemsetAsync((char*)d_ws + WS_CTL, 0, CTL_ZERO_BYTES, stream);
    Args a{};
    for (int i = 0; i < 19; ++i) a.in[i] = (const float*)d_in[i];
    a.out = (float*)d_out; a.ws = (unsigned char*)d_ws;
#if SINGLE_LAUNCH
    a.ph_lo = 0; a.ph_hi = 11;
    void* kargs[] = {(void*)&a};
    const hipError_t ce = hipLaunchCooperativeKernel((const void*)mega, dim3(grid), dim3(NWAVES * 64), kargs, LDS_BYTES, stream);
    if (ce != hipSuccess) fprintf(stderr, "kernel_launch: cooperative launch failed: %s (grid %d)\n", hipGetErrorName(ce), grid);
#else
    for (int k = 0; k < 11; ++k) { a.ph_lo = k; a.ph_hi = k + 1; hipLaunchKernelGGL(mega, dim3(grid), dim3(NWAVES * 64), LDS_BYTES, stream, a); }
#endif
    const hipError_t le = hipPeekAtLastError();
    if (le != hipSuccess) fprintf(stderr, "kernel_launch: launch failed: %s\n", hipGetErrorName(le));
}
```
